# Optimizing an MI355X kernel written in HIP

```python
import math
import jax, jax.numpy as jnp
from jax import lax
import numpy as np

D_MODEL = 1024
BATCH = 4
SEQ = 8192
DEPTH = 1
DEC_BATCH = 32
DEC_SEQ = 4
PAST_LEN = 16384
PAGE_SIZE = 128

EXPAND = 2
D_MIX = EXPAND * D_MODEL
D_ATTN = D_MIX // 2
D_CONV = D_MIX - D_ATTN
HEAD_DIM = 64
N_HEADS = D_ATTN // HEAD_DIM
N_KV = 2
HPG = N_HEADS // N_KV
D_KV = N_KV * HEAD_DIM
BLK = 64
N_SEL = 16
WINDOW = 512
CMP_HID = 2 * HEAD_DIM
CONV_W = 3
N_BUCKETS = 32
MAX_DIST = 128
Q_BLOCK = 128
EPS = 1e-6
NEG = -1e30
PROJ_SIZES = (D_ATTN, D_KV, D_KV, D_KV, D_KV, D_KV, D_KV, 3 * N_HEADS, D_CONV, D_CONV, D_CONV, D_MIX)
D_IN = sum(PROJ_SIZES)

kernel_name = "hymba_nsa_shortconv_adaln_step"


def rmsnorm(x, g):
    xf = x.astype(jnp.float32)
    y = xf * lax.rsqrt(jnp.mean(xf * xf, axis=-1, keepdims=True) + EPS)
    return (y * g.astype(jnp.float32)).astype(x.dtype)


def t5_bucket(dist):
    n = jnp.maximum(dist, 0)
    max_exact = N_BUCKETS // 2
    nf = jnp.maximum(n, max_exact).astype(jnp.float32)
    large = max_exact + (jnp.log(nf / max_exact) / math.log(MAX_DIST / max_exact)
                         * (N_BUCKETS - max_exact)).astype(jnp.int32)
    return jnp.where(n < max_exact, n, jnp.minimum(large, N_BUCKETS - 1))


def masked_softmax(logits, mask):
    p = jax.nn.softmax(jnp.where(mask, logits.astype(jnp.float32), NEG), axis=-1)
    return p * jnp.any(mask, axis=-1, keepdims=True)


def split_proj(u):
    offs = np.cumsum((0,) + PROJ_SIZES)
    return [u[..., int(offs[i]):int(offs[i + 1])] for i in range(len(PROJ_SIZES))]


def modulate_project(x, c, ada_w, ada_b, norm_g, w_in):
    shift, scale, gate = jnp.split(c @ ada_w + ada_b, 3, axis=-1)
    h = rmsnorm(x, norm_g) * (1 + scale[:, None, :]) + shift[:, None, :]
    return split_proj(h @ w_in), gate


def kv_heads(t):
    return t.reshape(t.shape[0], t.shape[1], N_KV, HEAD_DIM)


def compress(kv, pe, w1, w2):
    b, l, g, d = kv.shape
    blocks = kv.reshape(b, l // BLK, BLK, g, d) + pe[None, None, :, None, :]
    flat = blocks.transpose(0, 1, 3, 2, 4).reshape(b, l // BLK, g, BLK * d)
    return jax.nn.silu(flat @ w1) @ w2


def to_blocks(k):
    b, l, g, d = k.shape
    return k.reshape(b, l // BLK, BLK, g, d).transpose(0, 3, 1, 2, 4)


def nsa_attend(q, gts, q_pos, k_cmp, v_cmp, k_sel, v_sel, k_win, v_win, win_pos, rel_bias):
    qs = q * (HEAD_DIM ** -0.5)
    nb = k_cmp.shape[1]
    blk_start = jnp.arange(nb, dtype=jnp.int32) * BLK
    blk_end = blk_start + BLK - 1
    tab = rel_bias.reshape(N_BUCKETS, N_KV, HPG)
    d_cmp = q_pos[:, None] - blk_end[None, :]
    m_cmp = d_cmp >= 0
    lg = jnp.einsum('bqghd,bngd->bghqn', qs, k_cmp) + tab[t5_bucket(d_cmp)].transpose(2, 3, 0, 1)
    p_cmp = masked_softmax(lg, m_cmp)
    o_cmp = jnp.einsum('bghqn,bngd->bqghd', p_cmp.astype(v_cmp.dtype), v_cmp)
    imp = p_cmp.sum(axis=2)
    score = jnp.where(m_cmp, imp, jnp.where(blk_start[None, :] <= q_pos[:, None], 2.0, -1.0))
    top_s, idx = lax.top_k(score, min(N_SEL, nb))
    gather = jax.vmap(jax.vmap(lambda kb, ix: kb[ix]))
    ks = gather(k_sel, idx)
    vs = gather(v_sel, idx)
    s_pos = idx[..., None] * BLK + jnp.arange(BLK, dtype=jnp.int32)
    d_sel = q_pos[None, None, :, None, None] - s_pos
    m_sel = (d_sel >= 0) & (top_s[..., None] >= 0)
    b_sel = jax.vmap(lambda tb, bk: tb[bk], in_axes=(1, 1), out_axes=1)(tab, t5_bucket(d_sel))
    lg = jnp.einsum('bqghd,bgqnkd->bghqnk', qs, ks) + b_sel.transpose(0, 1, 5, 2, 3, 4)
    shp = lg.shape
    p_sel = masked_softmax(lg.reshape(shp[:4] + (-1,)), m_sel.reshape(m_sel.shape[:3] + (-1,))[:, :, None])
    o_sel = jnp.einsum('bghqnk,bgqnkd->bqghd', p_sel.reshape(shp).astype(vs.dtype), vs)
    d_win = q_pos[:, None] - win_pos[None, :]
    m_win = (d_win >= 0) & (d_win <= WINDOW) & (win_pos[None, :] >= 0)
    lg = jnp.einsum('bqghd,bwgd->bghqw', qs, k_win) + tab[t5_bucket(d_win)].transpose(2, 3, 0, 1)
    p_win = masked_softmax(lg, m_win)
    o_win = jnp.einsum('bghqw,bwgd->bqghd', p_win.astype(v_win.dtype), v_win)
    g = jax.nn.sigmoid(gts.astype(jnp.float32)).astype(q.dtype)[..., None]
    return g[:, :, 0] * o_cmp + g[:, :, 1] * o_sel + g[:, :, 2] * o_win


def nsa_prompt(q, gts, kc, vc, ksl, vsl, kw, vw, cmpw, rel_bias):
    b, s = q.shape[:2]
    k_cmp, v_cmp = compress(kc, *cmpw[:3]), compress(vc, *cmpw[3:])
    k_sel, v_sel = to_blocks(ksl), to_blocks(vsl)
    pad = ((0, 0), (WINDOW, 0), (0, 0), (0, 0))
    kw_pad, vw_pad = jnp.pad(kw, pad), jnp.pad(vw, pad)

    def q_block(i):
        s0 = i * Q_BLOCK
        qb = lax.dynamic_slice_in_dim(q, s0, Q_BLOCK, axis=1)
        gb = lax.dynamic_slice_in_dim(gts, s0, Q_BLOCK, axis=1)
        kwb = lax.dynamic_slice_in_dim(kw_pad, s0, WINDOW + Q_BLOCK, axis=1)
        vwb = lax.dynamic_slice_in_dim(vw_pad, s0, WINDOW + Q_BLOCK, axis=1)
        q_pos = s0 + jnp.arange(Q_BLOCK, dtype=jnp.int32)
        w_pos = s0 - WINDOW + jnp.arange(WINDOW + Q_BLOCK, dtype=jnp.int32)
        return nsa_attend(qb, gb, q_pos, k_cmp, v_cmp, k_sel, v_sel, kwb, vwb, w_pos, rel_bias)

    o = lax.map(q_block, jnp.arange(s // Q_BLOCK, dtype=jnp.int32))
    return jnp.moveaxis(o, 0, 1).reshape(b, s, D_ATTN)


def nsa_sample(q, gts, kc, vc, ksl, vsl, kw, vw, past_kc, past_vc, past_ks, past_vs,
               buf_kw, buf_vw, cmpw, rel_bias):
    b, t = q.shape[:2]
    past = past_kc.shape[1]
    pad_len = (-(past + t)) % BLK

    def full(p, n):
        return jnp.pad(jnp.concatenate([p, n], axis=1), ((0, 0), (0, pad_len), (0, 0), (0, 0)))

    k_cmp, v_cmp = compress(full(past_kc, kc), *cmpw[:3]), compress(full(past_vc, vc), *cmpw[3:])
    k_sel, v_sel = to_blocks(full(past_ks, ksl)), to_blocks(full(past_vs, vsl))
    k_win = jnp.concatenate([buf_kw, kw], axis=1)
    v_win = jnp.concatenate([buf_vw, vw], axis=1)
    q_pos = past + jnp.arange(t, dtype=jnp.int32)
    w_pos = past - buf_kw.shape[1] + jnp.arange(buf_kw.shape[1] + t, dtype=jnp.int32)
    o = nsa_attend(q, gts, q_pos, k_cmp, v_cmp, k_sel, v_sel, k_win, v_win, w_pos, rel_bias)
    return o.reshape(b, t, D_ATTN)


def short_conv(u_pad, w):
    t = u_pad.shape[1] - (CONV_W - 1)
    return sum(w[k] * u_pad[:, k:k + t] for k in range(CONV_W))


def merge_output(x, gate, o_attn, y_conv, z, w_out):
    z_a, z_c = z[..., :D_ATTN], z[..., D_ATTN:]
    o = jnp.concatenate([o_attn * jax.nn.silu(z_a), y_conv * jax.nn.silu(z_c)], axis=-1) @ w_out
    return x + gate[:, None, :] * o


def gather_pages(cache, page_table):
    g = cache[page_table]
    return g.reshape(g.shape[0], g.shape[1] * g.shape[2], g.shape[3], g.shape[4])


def setup_inputs(seed: int = 0) -> dict:
    key = jax.random.key(seed)
    ks = jax.random.split(key, 32)
    n_pages = PAST_LEN // PAGE_SIZE
    n_used = DEC_BATCH * n_pages
    n_pool = n_used + n_used // 4
    win_buf = min(WINDOW, PAST_LEN)

    def nrm(k, shape, s=1.0):
        return s * jax.random.normal(k, shape, jnp.float32)

    page_table = jax.random.permutation(ks[0], n_pool)[:n_used].reshape(DEC_BATCH, n_pages).astype(jnp.int32)
    kv_page = (DEPTH, n_pool, PAGE_SIZE, N_KV, HEAD_DIM)
    kv_win = (DEPTH, DEC_BATCH, win_buf, N_KV, HEAD_DIM)
    return {
        "x_prompt": nrm(ks[1], (BATCH, SEQ, D_MODEL)),
        "x_sample": nrm(ks[2], (DEC_BATCH, DEC_SEQ, D_MODEL)),
        "cache_k_cmp": nrm(ks[3], kv_page),
        "cache_v_cmp": nrm(ks[4], kv_page),
        "cache_k_slc": nrm(ks[5], kv_page),
        "cache_v_slc": nrm(ks[6], kv_page),
        "cache_k_win": nrm(ks[7], kv_win),
        "cache_v_win": nrm(ks[8], kv_win),
        "state_conv": nrm(ks[9], (DEPTH, DEC_BATCH, CONV_W - 1, D_CONV)),
        "page_table": page_table,
        "c_prompt": nrm(ks[10], (BATCH, D_MODEL)),
        "c_sample": nrm(ks[11], (DEC_BATCH, D_MODEL)),
        "ada_w": nrm(ks[12], (DEPTH, D_MODEL, 3 * D_MODEL), 0.5 * D_MODEL ** -0.5),
        "ada_b": nrm(ks[13], (DEPTH, 3 * D_MODEL), 0.02),
        "norm_g": 1.0 + nrm(ks[14], (DEPTH, D_MODEL), 0.02),
        "w_in": nrm(ks[15], (DEPTH, D_MODEL, D_IN), D_MODEL ** -0.5),
        "cmp_pe_k": nrm(ks[16], (DEPTH, BLK, HEAD_DIM), 0.1),
        "cmp_w1_k": nrm(ks[17], (DEPTH, BLK * HEAD_DIM, CMP_HID), (BLK * HEAD_DIM) ** -0.5),
        "cmp_w2_k": nrm(ks[18], (DEPTH, CMP_HID, HEAD_DIM), CMP_HID ** -0.5),
        "cmp_pe_v": nrm(ks[19], (DEPTH, BLK, HEAD_DIM), 0.1),
        "cmp_w1_v": nrm(ks[20], (DEPTH, BLK * HEAD_DIM, CMP_HID), (BLK * HEAD_DIM) ** -0.5),
        "cmp_w2_v": nrm(ks[21], (DEPTH, CMP_HID, HEAD_DIM), CMP_HID ** -0.5),
        "conv_w": nrm(ks[22], (DEPTH, CONV_W, D_CONV), 0.5),
        "w_out": nrm(ks[23], (DEPTH, D_MIX, D_MODEL), D_MIX ** -0.5),
        "rel_bias": nrm(ks[24], (N_BUCKETS, N_HEADS), 0.5),
        "final_g": 1.0 + nrm(ks[25], (D_MODEL,), 0.02),
    }


def reference(x_prompt, x_sample, cache_k_cmp, cache_v_cmp, cache_k_slc, cache_v_slc,
              cache_k_win, cache_v_win, state_conv, page_table, c_prompt, c_sample,
              ada_w, ada_b, norm_g, w_in, cmp_pe_k, cmp_w1_k, cmp_w2_k, cmp_pe_v, cmp_w1_v,
              cmp_w2_v, conv_w, w_out, rel_bias, final_g):
    xp, xs = x_prompt, x_sample
    prompt_states, sample_states = [], []
    for l in range(DEPTH):
        cmpw = (cmp_pe_k[l], cmp_w1_k[l], cmp_w2_k[l], cmp_pe_v[l], cmp_w1_v[l], cmp_w2_v[l])
        (q, kc, vc, ksl, vsl, kw, vw, gts, hc, bc, cc, z), gate = modulate_project(
            xp, c_prompt, ada_w[l], ada_b[l], norm_g[l], w_in[l])
        b, s = q.shape[:2]
        q = q.reshape(b, s, N_KV, HPG, HEAD_DIM)
        gts = gts.reshape(b, s, 3, N_KV, HPG)
        kc, vc, ksl, vsl, kw, vw = (kv_heads(t) for t in (kc, vc, ksl, vsl, kw, vw))
        o_attn = nsa_prompt(q, gts, kc, vc, ksl, vsl, kw, vw, cmpw, rel_bias)
        u = cc * hc
        y_conv = bc * short_conv(jnp.pad(u, ((0, 0), (CONV_W - 1, 0), (0, 0))), conv_w[l])
        xp = merge_output(xp, gate, o_attn, y_conv, z, w_out[l])
        w_keep = min(WINDOW, s)
        prompt_states.append((kc, vc, ksl, vsl, kw[:, -w_keep:], vw[:, -w_keep:], u[:, -(CONV_W - 1):]))
        (q, kc, vc, ksl, vsl, kw, vw, gts, hc, bc, cc, z), gate = modulate_project(
            xs, c_sample, ada_w[l], ada_b[l], norm_g[l], w_in[l])
        b, t = q.shape[:2]
        q = q.reshape(b, t, N_KV, HPG, HEAD_DIM)
        gts = gts.reshape(b, t, 3, N_KV, HPG)
        kc, vc, ksl, vsl, kw, vw = (kv_heads(a) for a in (kc, vc, ksl, vsl, kw, vw))
        buf_kw, buf_vw = cache_k_win[l], cache_v_win[l]
        o_attn = nsa_sample(q, gts, kc, vc, ksl, vsl, kw, vw,
                            gather_pages(cache_k_cmp[l], page_table), gather_pages(cache_v_cmp[l], page_table),
                            gather_pages(cache_k_slc[l], page_table), gather_pages(cache_v_slc[l], page_table),
                            buf_kw, buf_vw, cmpw, rel_bias)
        u = cc * hc
        u_pad = jnp.concatenate([state_conv[l].astype(u.dtype), u], axis=1)
        y_conv = bc * short_conv(u_pad, conv_w[l])
        xs = merge_output(xs, gate, o_attn, y_conv, z, w_out[l])
        nbuf = buf_kw.shape[1]
        new_kw = jnp.concatenate([buf_kw, kw], axis=1)[:, -nbuf:]
        new_vw = jnp.concatenate([buf_vw, vw], axis=1)[:, -nbuf:]
        sample_states.append((kc, vc, ksl, vsl, new_kw, new_vw, u_pad[:, -(CONV_W - 1):]))
    y_prompt = rmsnorm(xp, final_g)
    y_sample = rmsnorm(xs, final_g)
    p_kc, p_vc, p_ks, p_vs, p_kw, p_vw, p_cv = (jnp.stack(a) for a in zip(*prompt_states))
    s_kc, s_vc, s_ks, s_vs, s_kw, s_vw, s_cv = (jnp.stack(a) for a in zip(*sample_states))
    return (y_prompt, y_sample, p_kc, p_vc, p_ks, p_vs, p_kw, p_vw, p_cv,
            s_kc, s_vc, s_ks, s_vs, s_kw, s_vw, s_cv)
```

```cpp
#include <hip/hip_runtime.h>
#include <cstdio>
#include <cstdint>

#define LAS __attribute__((address_space(3)))
#define GAS __attribute__((address_space(1)))
typedef unsigned short bf16_t;
typedef short bf16x8 __attribute__((ext_vector_type(8)));
typedef float f32x4 __attribute__((ext_vector_type(4)));
typedef unsigned u32x4 __attribute__((ext_vector_type(4)));
typedef unsigned u32x2 __attribute__((ext_vector_type(2)));

constexpr int DM = 1024, SEQ = 8192, NB = 4, DB = 32, DS = 4, PAST = 16384;
constexpr int NPR = NB * SEQ;
constexpr int NSR = DB * DS;
constexpr int MROWS = 33024;
constexpr int DIN = 6960, NIN_PAD = 7168, DMIX = 2048;
constexpr int C_Q = 0, C_KV = 1024, C_G = 1792, C_HC = 1840, C_BC = 2864, C_CC = 3888, C_ZA = 4912, C_ZC = 5936;
constexpr float LOG2E = 1.4426950408889634f;
constexpr float QSCALE = 0.125f * LOG2E;
constexpr float EPS = 1e-6f;
constexpr float NEG_INF = -__builtin_inff();

constexpr size_t O_YP = 0;
constexpr size_t O_YS = O_YP + (size_t)NPR * DM;
constexpr size_t O_PKC = O_YS + (size_t)NSR * DM;
constexpr size_t SZ_PKV = (size_t)NPR * 128;
constexpr size_t O_PKW = O_PKC + 4 * SZ_PKV;
constexpr size_t SZ_PW = (size_t)NB * 512 * 128;
constexpr size_t O_PCV = O_PKW + 2 * SZ_PW;
constexpr size_t O_SKC = O_PCV + (size_t)NB * 2 * 1024;
constexpr size_t SZ_SKV = (size_t)NSR * 128;
constexpr size_t O_SKW = O_SKC + 4 * SZ_SKV;
constexpr size_t SZ_SW = (size_t)DB * 512 * 128;
constexpr size_t O_SCV = O_SKW + 2 * SZ_SW;
constexpr size_t O_END = O_SCV + (size_t)DB * 2 * 1024;
static_assert(O_END == 55320576, "output size");

constexpr size_t MiB = 1u << 20;
constexpr size_t WS_CTL = 0, CTL_ZERO_BYTES = 1 * MiB;
constexpr size_t WS_MOD = 1 * MiB;
constexpr size_t WS_BT = 1 * MiB + 512 * 1024;
constexpr size_t WS_B1 = WS_BT + 16384;
constexpr size_t WS_WINT = 2 * MiB;
constexpr size_t WS_WOUTT = 18 * MiB;
constexpr size_t WS_W1T = 22 * MiB;
constexpr size_t WS_KCMPP = 24 * MiB;
constexpr size_t WS_VCMPT = 24 * MiB + 512 * 1024;
constexpr size_t WS_KCMPS = 25 * MiB;
constexpr size_t WS_VCMPS = 29 * MiB;
constexpr size_t WS_G = 33 * MiB;
constexpr size_t WS_RSQ = 40 * MiB;
constexpr size_t WS_H = 48 * MiB;
constexpr size_t WS_Q = 114 * MiB;
constexpr size_t WS_SZA = 179 * MiB;
constexpr size_t WS_U = 244 * MiB;
constexpr size_t WS_BCZ = 309 * MiB;
constexpr size_t WS_OWIN = 374 * MiB;
constexpr size_t WS_A2 = 439 * MiB;
constexpr size_t WS_KC = 568 * MiB;
constexpr size_t WS_VC = 576 * MiB, WS_KSL = 584 * MiB, WS_KW = 592 * MiB, WS_VSLT = 600 * MiB, WS_VWT = 608 * MiB;
constexpr size_t WS_END = 616 * MiB;

constexpr int LDS_CTL = 147456;
constexpr int LDS_BYTES = 147456 + 1024;

__device__ __forceinline__ unsigned pk_bf16(float lo, float hi) { unsigned r; asm("v_cvt_pk_bf16_f32 %0, %1, %2" : "=v"(r) : "v"(lo), "v"(hi)); return r; }
__device__ __forceinline__ float bf2f(unsigned short b) { return __uint_as_float(((unsigned)b) << 16); }
__device__ __forceinline__ float bflo(unsigned w) { return __uint_as_float(w << 16); }
__device__ __forceinline__ float bfhi(unsigned w) { return __uint_as_float(w & 0xffff0000u); }
__device__ __forceinline__ float fexp2(float x) { return __builtin_amdgcn_exp2f(x); }
__device__ __forceinline__ float frcp(float x) { return __builtin_amdgcn_rcpf(x); }
__device__ __forceinline__ float sigmoidf_(float x) { return frcp(1.f + fexp2(-LOG2E * x)); }
__device__ __forceinline__ float siluf_(float x) { return x * sigmoidf_(x); }
__device__ __forceinline__ float wave_sum(float v) {
#pragma unroll
    for (int o = 1; o < 64; o <<= 1) v += __shfl_xor(v, o);
    return v;
}
__device__ __forceinline__ float wave_max(float v) {
#pragma unroll
    for (int o = 1; o < 64; o <<= 1) v = fmaxf(v, __shfl_xor(v, o));
    return v;
}
#define LDS_WAIT() asm volatile("s_waitcnt lgkmcnt(0)" ::: "memory")
#define VM_WAIT() asm volatile("s_waitcnt vmcnt(0)" ::: "memory")

#define XB_TMO      128
#define XB_XCNT(j)  (256  + 64 * (j))
#define XB_XSUB(j)  (1280 + 64 * (j))
#define XB_XGEN(j)  (2304 + 64 * (j))
#define XB_TOP      3328
#define XB_TOPGEN   3392
#define XCD_BAR_WORDS 3456
#define XB_SPIN_CAP (1u << 18)
__device__ __forceinline__ unsigned xb_ld(unsigned* p)              { return __hip_atomic_load(p, __ATOMIC_RELAXED, __HIP_MEMORY_SCOPE_AGENT); }
__device__ __forceinline__ unsigned xb_add(unsigned* p, unsigned v) { return __hip_atomic_fetch_add(p, v, __ATOMIC_RELAXED, __HIP_MEMORY_SCOPE_AGENT); }
__device__ __forceinline__ unsigned xb_xcc_id() { return (unsigned)__builtin_amdgcn_s_getreg((3 << 11) | 20) & 0xFu; }
#define XB_SPIN(cond, bar) do { unsigned _sp = 0; while (cond) { __builtin_amdgcn_s_sleep(1); \
    if ((++_sp & 255u) == 0u) { if (xb_ld(&(bar)[XB_TMO])) break; if (_sp > XB_SPIN_CAP) { atomicAdd(&(bar)[XB_TMO], 1u); break; } } } } while (0)
struct XcdBarrier { unsigned* bar; unsigned x; volatile LAS unsigned* st; };
__device__ __forceinline__ XcdBarrier xcd_barrier_post(unsigned* bar, volatile LAS unsigned* st) {
    XcdBarrier b; b.bar = bar; b.x = xb_xcc_id(); b.st = st;
    if (threadIdx.x == 0) (void)xb_add(&bar[XB_XCNT(b.x)], 1u);
    return b;
}
__device__ __forceinline__ void xcd_barrier_complete(unsigned* bar, unsigned x, unsigned& nloc, unsigned& nx) {
    const unsigned G = gridDim.x * gridDim.y * gridDim.z;
    unsigned sum, cnt, mine, sp = 0u;
    for (;;) {
        sum = 0u; cnt = 0u; mine = 0u;
#pragma unroll
        for (unsigned j = 0; j < 16; ++j) { const unsigned c = xb_ld(&bar[XB_XCNT(j)]); sum += c; cnt += (c > 0u) ? 1u : 0u; mine = (j == x) ? c : mine; }
        if (sum == G) break;
        __builtin_amdgcn_s_sleep(1);
        if ((++sp & 255u) == 0u) { if (xb_ld(&bar[XB_TMO])) break; if (sp > XB_SPIN_CAP) { atomicAdd(&bar[XB_TMO], 1u); break; } }
    }
    nloc = mine > 0u ? mine : 1u; nx = cnt > 0u ? cnt : 1u;
}
__device__ __forceinline__ void xcd_barrier(const XcdBarrier& b) {
    asm volatile("s_waitcnt vmcnt(0)" ::: "memory");
    __syncthreads();
    if (threadIdx.x == 0) {
        unsigned* bar = b.bar;
        __builtin_amdgcn_s_waitcnt(0);
        unsigned nloc = b.st[0], nx = b.st[1];
        if (nloc == 0u) { xcd_barrier_complete(bar, b.x, nloc, nx); b.st[0] = nloc; b.st[1] = nx; }
        const unsigned old = xb_add(&bar[XB_XSUB(b.x)], 1u);
        const unsigned gen = old / nloc;
        if (old + 1u == (gen + 1u) * nloc) {
            __builtin_amdgcn_fence(__ATOMIC_RELEASE, "agent");
            asm volatile("s_waitcnt vmcnt(0)" ::: "memory");
            const unsigned og = xb_add(&bar[XB_TOP], 1u);
            const unsigned tg = og / nx;
            if (og + 1u == (tg + 1u) * nx) xb_add(&bar[XB_TOPGEN], 1u);
            else XB_SPIN(xb_ld(&bar[XB_TOPGEN]) == tg, bar);
            __builtin_amdgcn_fence(__ATOMIC_ACQUIRE, "agent");
            xb_add(&bar[XB_XGEN(b.x)], 1u);
            asm volatile("s_waitcnt vmcnt(0)" ::: "memory");
        } else {
            XB_SPIN(xb_ld(&bar[XB_XGEN(b.x)]) == gen, bar);
            __builtin_amdgcn_fence(__ATOMIC_ACQUIRE, "agent");
            asm volatile("s_waitcnt vmcnt(0)" ::: "memory");
        }
    }
    __syncthreads();
}

namespace pg8 {
constexpr int BM = 256, BK = 64, HALF = 128, HTB = HALF * BK * 2, STAGE_BYTES = 8 * HTB, NXCD = 8, WGM = 8;
__host__ __device__ __forceinline__ int lds_byte(int r, int c) { const int st = (r >> 4) * 2 + (c >> 5), rr = r & 15, cc = c & 31, ob = rr * 64 + cc * 2; return st * 1024 + (ob ^ (((ob >> 9) & 1) << 5)); }
__host__ __device__ __forceinline__ void stage_rc(int b, int& R, int& C) { const int st = b / 1024, sb = b % 1024, swz = sb ^ (((sb >> 9) & 1) << 5); R = (st >> 1) * 16 + swz / 64; C = (st & 1) * 32 + (swz % 64) / 2; }
struct Unit { int pm, pn; };
struct Gemm { const bf16_t* A; const bf16_t* Bt; int M, N, K; };
struct StaticOrder {
    int nM, nN, nwg, G, c;
    __host__ __device__ void init(int M, int N, int G_, int c_) { nM = M / BM; nN = N / BM; nwg = nM * nN; G = G_; c = c_; }
    __host__ __device__ bool next(int i, Unit& u) const {
        const long L = (long)i * G + c; if (L >= nwg) return false;
        int wgid = (int)L; { const int q = nwg / NXCD, r = nwg % NXCD, xcd = wgid % NXCD, off = wgid / NXCD; wgid = (xcd < r ? xcd * (q + 1) : r * (q + 1) + (xcd - r) * q) + off; }
        const int nig = WGM * nN, gid = wgid / nig, fm = gid * WGM, gsz = (nM - fm) < WGM ? (nM - fm) : WGM;
        u.pm = fm + ((wgid % nig) % gsz); u.pn = (wgid % nig) / gsz; return true;
    }
    __device__ __forceinline__ void a_ready(const Unit&) const {}
    __device__ __forceinline__ void done(const Unit&) const {}
};
template <class Epi, class Sched, bool ALIGN_EPI = false, bool SP2 = false>
__device__ __forceinline__ void gemm_phase(LAS unsigned char* lds, const Gemm g, const Sched& S, const Epi& E) {
    const int tid = threadIdx.x, wid = __builtin_amdgcn_readfirstlane(tid >> 6), lane = tid & 63, wr = wid >> 2, wc = wid & 3, fr = lane & 15, fq = lane >> 4;
    const int K = g.K, nt = K / BK;
    unsigned voffA[2], voffB[2];
#pragma unroll
    for (int i = 0; i < 2; ++i) { int R, C; stage_rc(tid * 16 + i * 8192, R, C); voffA[i] = (unsigned)(R * K + C) * 2u; voffB[i] = (unsigned)(R * K + C) * 2u; }
    const size_t kstep = (size_t)(BK * 2);
    const size_t hstep = (size_t)HALF * K * 2;
    const size_t tstep = 2 * hstep;
    const unsigned ldsw = (unsigned)wid * 1024u;
    const int aoff = lds_byte(wr * 64 + fr, fq * 8), boff = lds_byte(wc * 32 + fr, fq * 8);
#define PG8_SA(b, h) (((b) * 2 + (h)) * HTB)
#define PG8_SB(b, h) ((4 + (b) * 2 + (h)) * HTB)
#define PG8_STAGE(bufoff, gbase, voff) do { _Pragma("unroll") for (int _i = 0; _i < 2; ++_i) \
        __builtin_amdgcn_global_load_lds((const unsigned*)((const char*)(gbase) + (voff)[_i]), (LAS unsigned*)(lds + (bufoff) + ldsw + _i * 8192), 16, 0, 0); } while (0)
#define PG8_LDA(dst, b, h) do { _Pragma("unroll") for (int m = 0; m < 4; ++m) _Pragma("unroll") for (int k = 0; k < 2; ++k) dst[m][k] = *(const LAS bf16x8*)(lds + PG8_SA(b, h) + aoff + m * 2048 + k * 1024); } while (0)
#define PG8_LDB(dst, b, h) do { _Pragma("unroll") for (int n = 0; n < 2; ++n) _Pragma("unroll") for (int k = 0; k < 2; ++k) dst[n][k] = *(const LAS bf16x8*)(lds + PG8_SB(b, h) + boff + n * 2048 + k * 1024); } while (0)
#define PG8_MMA(ai, bj, At, Bt) do { __builtin_amdgcn_s_setprio(1); _Pragma("unroll") for (int m = 0; m < 4; ++m) _Pragma("unroll") for (int n = 0; n < 2; ++n) _Pragma("unroll") for (int k = 0; k < 2; ++k) \
        acc[ai][bj][m][n] = __builtin_amdgcn_mfma_f32_16x16x32_bf16(Bt[n][k], At[m][k], acc[ai][bj][m][n], 0, 0, 0); __builtin_amdgcn_s_setprio(0); } while (0)
#define PG8_WAIT_V(n) asm volatile("s_waitcnt vmcnt(" #n ")" ::: "memory")
#define PG8_WAIT_L(n) asm volatile("s_waitcnt lgkmcnt(" #n ")" ::: "memory")
#define PG8_BAR __builtin_amdgcn_s_barrier()
#define PG8_SCHED __builtin_amdgcn_sched_barrier(0)
    Unit cur, nxt; int ui = 0;
    if (!S.next(0, cur)) return;
    f32x4 acc[2][2][4][2];
#pragma unroll
    for (int a = 0; a < 2; ++a)
#pragma unroll
        for (int b = 0; b < 2; ++b)
#pragma unroll
            for (int m = 0; m < 4; ++m)
#pragma unroll
                for (int n = 0; n < 2; ++n) acc[a][b][m][n] = (f32x4){0.f, 0.f, 0.f, 0.f};
    bf16x8 At[4][2], B0[2][2], B1[2][2];
    const char* cA = (const char*)g.A + (size_t)cur.pm * tstep; const char* cB = (const char*)g.Bt + (size_t)cur.pn * tstep;
    S.a_ready(cur);
    if constexpr (SP2) {
        PG8_STAGE(PG8_SB(0, 0), cB, voffB); PG8_STAGE(PG8_SB(0, 1), cB + hstep, voffB); PG8_STAGE(PG8_SA(0, 0), cA, voffA); PG8_STAGE(PG8_SA(0, 1), cA + hstep, voffA);
        if (wr == 1) PG8_BAR;
        PG8_WAIT_V(2); PG8_BAR;
        PG8_STAGE(PG8_SB(1, 0), cB + kstep, voffB); PG8_STAGE(PG8_SA(1, 0), cA + kstep, voffA); PG8_STAGE(PG8_SB(1, 1), cB + hstep + kstep, voffB);
        PG8_WAIT_V(6); PG8_BAR;
    } else {
        PG8_STAGE(PG8_SB(0, 0), cB, voffB); PG8_STAGE(PG8_SA(0, 0), cA, voffA); PG8_STAGE(PG8_SB(0, 1), cB + hstep, voffB); PG8_STAGE(PG8_SA(0, 1), cA + hstep, voffA);
        if (wr == 1) PG8_BAR;
        PG8_WAIT_V(4); PG8_BAR;
        PG8_STAGE(PG8_SB(1, 0), cB + kstep, voffB); PG8_STAGE(PG8_SA(1, 0), cA + kstep, voffA); PG8_STAGE(PG8_SB(1, 1), cB + hstep + kstep, voffB);
        PG8_WAIT_V(6); PG8_BAR;
    }
    for (;;) {
        const bool has_next = S.next(ui + 1, nxt);
        const char* nA = has_next ? (const char*)g.A + (size_t)nxt.pm * tstep : cA; const char* nB = has_next ? (const char*)g.Bt + (size_t)nxt.pn * tstep : cB;
        for (int t = 0; t < nt; t += 2) {
            const bool last = (t == nt - 2);
            const char* a1 = cA + (size_t)(t + 1) * kstep;
            const char* a2 = last ? nA : cA + (size_t)(t + 2) * kstep; const char* b2 = last ? nB : cB + (size_t)(t + 2) * kstep;
            const char* a3 = a2 + kstep; const char* b3 = b2 + kstep;
            if (last && has_next) S.a_ready(nxt);
            if constexpr (SP2) {
            PG8_LDB(B0, 0, 0); PG8_LDB(B1, 0, 1); PG8_SCHED; PG8_LDA(At, 0, 0); PG8_STAGE(PG8_SA(1, 1), a1 + hstep, voffA);
            PG8_WAIT_V(8); PG8_WAIT_L(0); PG8_BAR; PG8_MMA(0, 0, At, B0); PG8_MMA(0, 1, At, B1); PG8_BAR; PG8_SCHED;
            PG8_LDA(At, 0, 1); PG8_STAGE(PG8_SB(0, 0), b2, voffB); PG8_STAGE(PG8_SB(0, 1), b2 + hstep, voffB); PG8_STAGE(PG8_SA(0, 0), a2, voffA);
            PG8_WAIT_V(8); PG8_WAIT_L(0); PG8_BAR; PG8_MMA(1, 0, At, B0); PG8_MMA(1, 1, At, B1); PG8_BAR; PG8_SCHED;
            PG8_LDB(B0, 1, 0); PG8_LDB(B1, 1, 1); PG8_SCHED; PG8_LDA(At, 1, 0); PG8_STAGE(PG8_SA(0, 1), a2 + hstep, voffA);
            PG8_WAIT_V(8); PG8_WAIT_L(0); PG8_BAR; PG8_MMA(0, 0, At, B0); PG8_MMA(0, 1, At, B1); PG8_BAR; PG8_SCHED;
            PG8_LDA(At, 1, 1); PG8_STAGE(PG8_SB(1, 0), b3, voffB); PG8_STAGE(PG8_SB(1, 1), b3 + hstep, voffB); PG8_STAGE(PG8_SA(1, 0), a3, voffA);
            PG8_WAIT_V(8); PG8_WAIT_L(0); PG8_BAR; PG8_MMA(1, 0, At, B0); PG8_MMA(1, 1, At, B1); PG8_BAR; PG8_SCHED;
            } else {
            PG8_LDB(B0, 0, 0); PG8_SCHED; PG8_LDA(At, 0, 0); PG8_STAGE(PG8_SA(1, 1), a1 + hstep, voffA);
            PG8_WAIT_L(8); PG8_BAR; PG8_WAIT_L(0); PG8_MMA(0, 0, At, B0); PG8_BAR; PG8_SCHED;
            PG8_LDB(B1, 0, 1); PG8_STAGE(PG8_SB(0, 0), b2, voffB);
            PG8_BAR; PG8_WAIT_L(0); PG8_MMA(0, 1, At, B1); PG8_BAR;
            PG8_LDA(At, 0, 1); PG8_STAGE(PG8_SA(0, 0), a2, voffA);
            PG8_BAR; PG8_WAIT_L(0); PG8_MMA(1, 0, At, B0); PG8_BAR; PG8_SCHED;
            PG8_STAGE(PG8_SB(0, 1), b2 + hstep, voffB);
            PG8_WAIT_V(6); PG8_BAR; PG8_MMA(1, 1, At, B1); PG8_BAR;
            PG8_LDB(B0, 1, 0); PG8_SCHED; PG8_LDA(At, 1, 0); PG8_STAGE(PG8_SA(0, 1), a2 + hstep, voffA);
            PG8_WAIT_L(8); PG8_BAR; PG8_WAIT_L(0); PG8_MMA(0, 0, At, B0); PG8_BAR; PG8_SCHED;
            PG8_LDB(B1, 1, 1); PG8_STAGE(PG8_SB(1, 0), b3, voffB);
            PG8_BAR; PG8_WAIT_L(0); PG8_MMA(0, 1, At, B1); PG8_BAR;
            PG8_LDA(At, 1, 1); PG8_STAGE(PG8_SA(1, 0), a3, voffA);
            PG8_BAR; PG8_WAIT_L(0); PG8_MMA(1, 0, At, B0); PG8_BAR; PG8_SCHED;
            PG8_STAGE(PG8_SB(1, 1), b3 + hstep, voffB);
            PG8_WAIT_V(6); PG8_BAR; PG8_MMA(1, 1, At, B1); PG8_BAR;
            }
        }
        if constexpr (ALIGN_EPI) { if (wr == 0) PG8_BAR; }
        E(acc, cur, wr, wc, fr, fq); S.done(cur);
        if (!has_next) break;
#pragma unroll
        for (int a = 0; a < 2; ++a)
#pragma unroll
            for (int b = 0; b < 2; ++b)
#pragma unroll
                for (int m = 0; m < 4; ++m)
#pragma unroll
                    for (int n = 0; n < 2; ++n) acc[a][b][m][n] = (f32x4){0.f, 0.f, 0.f, 0.f};
        cur = nxt; cA = nA; cB = nB; ++ui;
        if constexpr (ALIGN_EPI) { if (wr == 1) PG8_BAR; }
    }
    PG8_WAIT_V(0);
    if constexpr (!ALIGN_EPI) { if (wr == 0) PG8_BAR; }
    PG8_BAR;
#undef PG8_SA
#undef PG8_SB
#undef PG8_STAGE
#undef PG8_LDA
#undef PG8_LDB
#undef PG8_MMA
#undef PG8_WAIT_V
#undef PG8_WAIT_L
#undef PG8_BAR
#undef PG8_SCHED
}
}

struct Args {
    const float* x_prompt; const float* x_sample;
    const float* cache_k_cmp; const float* cache_v_cmp; const float* cache_k_slc; const float* cache_v_slc;
    const float* cache_k_win; const float* cache_v_win; const float* state_conv; const int* page_table;
    const float* c_prompt; const float* c_sample; const float* ada_w; const float* ada_b; const float* norm_g; const float* w_in;
    const float* cmp_pe_k; const float* cmp_w1_k; const float* cmp_w2_k; const float* cmp_pe_v; const float* cmp_w1_v; const float* cmp_w2_v;
    const float* conv_w; const float* w_out; const float* rel_bias; const float* final_g;
    float* out; unsigned char* ws; int ph_lo, ph_hi;
};
struct Frame {
    LAS unsigned char* lds; int tid, lane, wave, G, bid;
};

__host__ __device__ __forceinline__ int vslot32(int kk) { return kk < 16 ? 8 * (kk >> 2) + (kk & 3) : 8 * ((kk - 16) >> 2) + 4 + (kk & 3); }
__host__ __device__ __forceinline__ int inv_perm32(int lo) { return 16 * ((lo >> 2) & 1) + 4 * (lo >> 3) + (lo & 3); }

__device__ __forceinline__ void transpose_item(const float* W, int ldw, int src0, int nvalid, bf16_t* WT, int K, int dst0, bool perm, int k0, LAS float* scr, int lane) {
    const int c = lane & 31;
#pragma unroll 8
    for (int i = 0; i < 32; ++i) { const int kk = 2 * i + (lane >> 5); scr[kk * 33 + c] = (c < nvalid) ? W[(size_t)(k0 + kk) * ldw + src0 + c] : 0.f; }
    LDS_WAIT(); asm volatile("" ::: "memory");
    const int c8 = lane & 7;
#pragma unroll
    for (int j = 0; j < 4; ++j) { const int n = (lane >> 3) + 8 * j; const LAS float* s = scr + (8 * c8) * 33 + n;
        u32x4 o; o.x = pk_bf16(s[0 * 33], s[1 * 33]); o.y = pk_bf16(s[2 * 33], s[3 * 33]); o.z = pk_bf16(s[4 * 33], s[5 * 33]); o.w = pk_bf16(s[6 * 33], s[7 * 33]);
        const int dn = perm ? inv_perm32(n) : n;
        *(u32x4*)(WT + (size_t)(dst0 + dn) * K + k0 + 8 * c8) = o; }
    LDS_WAIT(); asm volatile("" ::: "memory");
}
__device__ __forceinline__ void win_group_src(int pg, int& src0, int& nvalid) {
    const int pn = pg >> 3, bj = (pg >> 2) & 1, wc = pg & 3; nvalid = 32;
    if (pn < 4) src0 = C_Q + 256 * pn + 128 * bj + 32 * wc;
    else if (pn < 8) src0 = C_ZA + 256 * (pn - 4) + 128 * bj + 32 * wc;
    else if (pn < 11) src0 = C_KV + 128 * (2 * (pn - 8) + bj) + 32 * wc;
    else if (pn == 11) { src0 = C_G + 32 * wc; nvalid = bj ? 0 : (wc == 0 ? 32 : (wc == 1 ? 16 : 0)); if (nvalid == 0) src0 = 0; }
    else if (pn < 20) src0 = (bj ? C_CC : C_HC) + 128 * (pn - 12) + 32 * wc;
    else src0 = (bj ? C_ZC : C_BC) + 128 * (pn - 20) + 32 * wc;
}

__device__ __forceinline__ void p0a(const Args& a, Frame& F) {
    unsigned char* ws = a.ws;
    {
        LAS float* scr = (LAS float*)(F.lds + F.wave * 8704);
        const int gw = F.bid * 8 + F.wave, NGW = F.G * 8;
        constexpr int I_IN = 224 * 16, I_OUT = 32 * 32, I_W1 = 4 * 64;
        constexpr int NITEMS = I_IN + I_OUT + 2 * I_W1;
        for (int it = gw; it < NITEMS; it += NGW) {
            int r = it;
            if (r < I_IN) { const int pg = r >> 4, kb = r & 15; int src0, nv; win_group_src(pg, src0, nv);
                transpose_item(a.w_in, DIN, src0, nv, (bf16_t*)(ws + WS_WINT), DM, pg * 32, true, kb * 64, scr, F.lane); continue; }
            r -= I_IN;
            if (r < I_OUT) { const int pg = r >> 5, kb = r & 31;
                transpose_item(a.w_out, DM, pg * 32, 32, (bf16_t*)(ws + WS_WOUTT), DMIX, pg * 32, true, kb * 64, scr, F.lane); continue; }
            r -= I_OUT;
            const int kv = r >= I_W1; if (kv) r -= I_W1;
            { const int pg = r >> 6, kb = r & 63;
              transpose_item(kv ? a.cmp_w1_v : a.cmp_w1_k, 128, pg * 32, 32, (bf16_t*)(ws + WS_W1T) + (size_t)kv * 128 * 4096, 4096, pg * 32, false, kb * 64, scr, F.lane); }
        }
    }
    __syncthreads();
    {
        LAS float* CS = (LAS float*)(F.lds) + F.wave * (18 * 128);
        LAS float* RED = (LAS float*)(F.lds + 73728);
        float* MOD = (float*)(ws + WS_MOD);
        for (int job = F.bid; job < 96; job += F.G) {
            const int cg = job >> 1, rh = job & 1, n = cg * 64 + F.lane, kb = F.wave * 128;
            for (int i = F.lane; i < 18 * 128; i += 64) { const int r = rh * 18 + i / 128, k = kb + (i & 127);
                CS[i] = (r < 4) ? a.c_prompt[r * DM + k] : a.c_sample[(r - 4) * DM + k]; }
            LDS_WAIT(); asm volatile("" ::: "memory");
            float acc[18];
#pragma unroll
            for (int r = 0; r < 18; ++r) acc[r] = 0.f;
            for (int k4 = 0; k4 < 128; k4 += 4) {
                float w0 = a.ada_w[(size_t)(kb + k4) * 3072 + n], w1 = a.ada_w[(size_t)(kb + k4 + 1) * 3072 + n], w2 = a.ada_w[(size_t)(kb + k4 + 2) * 3072 + n], w3 = a.ada_w[(size_t)(kb + k4 + 3) * 3072 + n];
#pragma unroll
                for (int r = 0; r < 18; ++r) { const f32x4 c4 = *(const LAS f32x4*)(CS + r * 128 + k4); acc[r] += c4.x * w0 + c4.y * w1 + c4.z * w2 + c4.w * w3; }
            }
#pragma unroll
            for (int r = 0; r < 18; ++r) RED[(F.wave * 18 + r) * 64 + F.lane] = acc[r];
            __syncthreads();
            for (int o = F.tid; o < 18 * 64; o += 512) { const int r = o >> 6, l = o & 63; float s = 0.f;
#pragma unroll
                for (int w = 0; w < 8; ++w) s += RED[(w * 18 + r) * 64 + l];
                MOD[(rh * 18 + r) * 3072 + cg * 64 + l] = s + a.ada_b[cg * 64 + l]; }
            __syncthreads();
        }
    }
    if (F.bid == F.G - 1 || F.bid == F.G - 2) {
        const int kv = (F.bid == F.G - 1) ? 1 : 0; const float* pe = kv ? a.cmp_pe_v : a.cmp_pe_k; const float* w1 = kv ? a.cmp_w1_v : a.cmp_w1_k;
        LAS float* red = (LAS float*)(F.lds);
        const int n = F.tid & 127, part = F.tid >> 7; float s = 0.f;
        for (int k = part * 1024; k < part * 1024 + 1024; ++k) s += pe[k] * w1[(size_t)k * 128 + n];
        red[F.tid] = s; __syncthreads();
        if (F.tid < 128) ((float*)(ws + WS_B1))[kv * 128 + F.tid] = red[F.tid] + red[F.tid + 128] + red[F.tid + 256] + red[F.tid + 384];
        __syncthreads();
    }
    if (F.bid == F.G - 3) {
        float* BT = (float*)(ws + WS_BT);
        for (int i = F.tid; i < 129 * 16; i += 512) { const int d = i >> 4, hh = i & 15; int bk;
            if (d < 16) bk = d; else { int lg = 16 + (int)(log((double)d / 16.0) / log(8.0) * 16.0); bk = lg < 31 ? lg : 31; }
            BT[i] = a.rel_bias[bk * 16 + hh] * LOG2E; }
    }
    {
        const size_t per = (size_t)508 * 128 / 4;
        const size_t total = 2 * DB * per;
        for (size_t i = (size_t)F.bid * 512 + F.tid; i < total; i += (size_t)F.G * 512) {
            const int t = (int)(i / (DB * per)); const size_t r = i % (DB * per); const int sb = (int)(r / per); const size_t o = r % per;
            const f32x4* src = (const f32x4*)((t ? a.cache_v_win : a.cache_k_win) + ((size_t)sb * 512 + 4) * 128) + o;
            f32x4* dst = (f32x4*)(a.out + O_SKW + (size_t)t * SZ_SW + (size_t)sb * 512 * 128) + o;
            *dst = *src;
        }
    }
}

__device__ __forceinline__ void p0b_rows(const Args& a, Frame& F) {
    const float* MOD = (const float*)(a.ws + WS_MOD); bf16_t* H = (bf16_t*)(a.ws + WS_H);
    const int gw = F.bid * 8 + F.wave, NGW = F.G * 8;
    for (int row = gw; row < MROWS; row += NGW) {
        unsigned long long* o8 = (unsigned long long*)(H + (size_t)row * DM) + F.lane;
        if (row >= NPR + NSR) {
#pragma unroll
            for (int j = 0; j < 4; ++j) o8[64 * j] = 0ull;
            continue; }
        const float* xr; int mr;
        if (row < NPR) { xr = a.x_prompt + (size_t)row * DM; mr = row >> 13; } else { xr = a.x_sample + (size_t)(row - NPR) * DM; mr = 4 + ((row - NPR) >> 2); }
        const f32x4* x4 = (const f32x4*)xr + F.lane;
        f32x4 v[4]; float s = 0.f;
#pragma unroll
        for (int j = 0; j < 4; ++j) { v[j] = x4[64 * j]; s += (v[j].x * v[j].x + v[j].y * v[j].y) + (v[j].z * v[j].z + v[j].w * v[j].w); }
        const float rstd = 1.f / sqrtf(wave_sum(s) * (1.f / DM) + EPS);
        const float* shift = MOD + (size_t)mr * 3072; const float* scale = shift + 1024;
#pragma unroll
        for (int j = 0; j < 4; ++j) { const int c = 4 * F.lane + 256 * j;
            const f32x4 g = *(const f32x4*)(a.norm_g + c), sc = *(const f32x4*)(scale + c), sh = *(const f32x4*)(shift + c);
            const f32x4 y = (v[j] * rstd * g) * (sc + 1.f) + sh;
            o8[64 * j] = (unsigned long long)pk_bf16(y.x, y.y) | ((unsigned long long)pk_bf16(y.z, y.w) << 32); }
    }
}

struct EpiIn {
    float* out; unsigned char* ws;
    __device__ __forceinline__ void operator()(const f32x4 (&acc)[2][2][4][2], const pg8::Unit& u, int wr, int wc, int fr, int fq) const {
        const int pn = u.pn, lc0 = wc * 32 + fq * 8;
#pragma unroll
        for (int ai = 0; ai < 2; ++ai)
#pragma unroll
            for (int m = 0; m < 4; ++m) {
                const int row = u.pm * 256 + ai * 128 + wr * 64 + m * 16 + fr;
                if (row >= NPR + NSR) continue;
                const f32x4 a0 = acc[ai][0][m][0], a1 = acc[ai][0][m][1], b0 = acc[ai][1][m][0], b1 = acc[ai][1][m][1];
                if (pn < 4) {
                    bf16_t* d = (bf16_t*)(ws + WS_Q) + (size_t)row * DM + 256 * pn + lc0;
                    u32x4 w0, w1;
                    w0.x = pk_bf16(a0.x * QSCALE, a0.y * QSCALE); w0.y = pk_bf16(a0.z * QSCALE, a0.w * QSCALE); w0.z = pk_bf16(a1.x * QSCALE, a1.y * QSCALE); w0.w = pk_bf16(a1.z * QSCALE, a1.w * QSCALE);
                    w1.x = pk_bf16(b0.x * QSCALE, b0.y * QSCALE); w1.y = pk_bf16(b0.z * QSCALE, b0.w * QSCALE); w1.z = pk_bf16(b1.x * QSCALE, b1.y * QSCALE); w1.w = pk_bf16(b1.z * QSCALE, b1.w * QSCALE);
                    *(u32x4*)d = w0; *(u32x4*)(d + 128) = w1;
                } else if (pn < 8) {
                    bf16_t* d = (bf16_t*)(ws + WS_SZA) + (size_t)row * DM + 256 * (pn - 4) + lc0;
                    u32x4 w0, w1;
                    w0.x = pk_bf16(siluf_(a0.x), siluf_(a0.y)); w0.y = pk_bf16(siluf_(a0.z), siluf_(a0.w)); w0.z = pk_bf16(siluf_(a1.x), siluf_(a1.y)); w0.w = pk_bf16(siluf_(a1.z), siluf_(a1.w));
                    w1.x = pk_bf16(siluf_(b0.x), siluf_(b0.y)); w1.y = pk_bf16(siluf_(b0.z), siluf_(b0.w)); w1.z = pk_bf16(siluf_(b1.x), siluf_(b1.y)); w1.w = pk_bf16(siluf_(b1.z), siluf_(b1.w));
                    *(u32x4*)d = w0; *(u32x4*)(d + 128) = w1;
                } else if (pn < 11) {
#pragma unroll
                    for (int bj = 0; bj < 2; ++bj) {
                        const int ti = 2 * (pn - 8) + bj; const f32x4 v0 = bj ? b0 : a0, v1 = bj ? b1 : a1;
                        float* fo = nullptr;
                        if (row < NPR) {
                            const int s = row & (SEQ - 1), b = row >> 13;
                            if (ti < 4) fo = out + O_PKC + (size_t)ti * SZ_PKV + (size_t)row * 128 + lc0;
                            else if (s >= SEQ - 512) fo = out + O_PKW + (size_t)(ti - 4) * SZ_PW + ((size_t)b * 512 + (s - (SEQ - 512))) * 128 + lc0;
                            if (ti == 0 || ti == 1 || ti == 2 || ti == 4) {
                                const size_t base = ti == 0 ? WS_KC : ti == 1 ? WS_VC : ti == 2 ? WS_KSL : WS_KW;
                                u32x4 w; w.x = pk_bf16(v0.x, v0.y); w.y = pk_bf16(v0.z, v0.w); w.z = pk_bf16(v1.x, v1.y); w.w = pk_bf16(v1.z, v1.w);
                                *(u32x4*)((bf16_t*)(ws + base) + (size_t)row * 128 + lc0) = w;
                            } else {
                                bf16_t* vt = (bf16_t*)(ws + (ti == 3 ? WS_VSLT : WS_VWT));
                                const int g = lc0 >> 6, d0 = lc0 & 63, blk = s >> 6, kk = s & 63, slot = (kk & 32) + vslot32(kk & 31);
                                bf16_t* p = vt + (((size_t)(b * 2 + g) * 128 + blk) * 64 + d0) * 64 + slot;
                                const unsigned w0 = pk_bf16(v0.x, v0.y), w1 = pk_bf16(v0.z, v0.w), w2 = pk_bf16(v1.x, v1.y), w3 = pk_bf16(v1.z, v1.w);
                                p[0] = (bf16_t)w0; p[64] = (bf16_t)(w0 >> 16); p[128] = (bf16_t)w1; p[192] = (bf16_t)(w1 >> 16);
                                p[256] = (bf16_t)w2; p[320] = (bf16_t)(w2 >> 16); p[384] = (bf16_t)w3; p[448] = (bf16_t)(w3 >> 16);
                            }
                        } else {
                            const int sr = row - NPR, sb = sr >> 2, t = sr & 3;
                            if (ti < 4) fo = out + O_SKC + (size_t)ti * SZ_SKV + (size_t)sr * 128 + lc0;
                            else fo = out + O_SKW + (size_t)(ti - 4) * SZ_SW + ((size_t)sb * 512 + 508 + t) * 128 + lc0;
                        }
                        if (fo) { *(f32x4*)fo = v0; *(f32x4*)(fo + 4) = v1; }
                    }
                } else if (pn == 11) {
                    if (lc0 < 48) { float* d = (float*)(ws + WS_G) + (size_t)row * 48 + lc0;
                        *(f32x4*)d = (f32x4){sigmoidf_(a0.x), sigmoidf_(a0.y), sigmoidf_(a0.z), sigmoidf_(a0.w)};
                        *(f32x4*)(d + 4) = (f32x4){sigmoidf_(a1.x), sigmoidf_(a1.y), sigmoidf_(a1.z), sigmoidf_(a1.w)}; }
                } else if (pn < 20) {
                    const int ch = 128 * (pn - 12) + lc0; const f32x4 u0 = a0 * b0, u1 = a1 * b1;
                    u32x4 w; w.x = pk_bf16(u0.x, u0.y); w.y = pk_bf16(u0.z, u0.w); w.z = pk_bf16(u1.x, u1.y); w.w = pk_bf16(u1.z, u1.w);
                    *(u32x4*)((bf16_t*)(ws + WS_U) + (size_t)row * DM + ch) = w;
                    float* fo = nullptr;
                    if (row < NPR) { const int s = row & (SEQ - 1); if (s >= SEQ - 2) fo = out + O_PCV + ((size_t)(row >> 13) * 2 + (s - (SEQ - 2))) * 1024 + ch; }
                    else { const int sr = row - NPR, t = sr & 3; if (t >= 2) fo = out + O_SCV + ((size_t)(sr >> 2) * 2 + (t - 2)) * 1024 + ch; }
                    if (fo) { *(f32x4*)fo = u0; *(f32x4*)(fo + 4) = u1; }
                } else {
                    const int ch = 128 * (pn - 20) + lc0;
                    u32x4 w; w.x = pk_bf16(a0.x * siluf_(b0.x), a0.y * siluf_(b0.y)); w.y = pk_bf16(a0.z * siluf_(b0.z), a0.w * siluf_(b0.w));
                    w.z = pk_bf16(a1.x * siluf_(b1.x), a1.y * siluf_(b1.y)); w.w = pk_bf16(a1.z * siluf_(b1.z), a1.w * siluf_(b1.w));
                    *(u32x4*)((bf16_t*)(ws + WS_BCZ) + (size_t)row * DM + ch) = w;
                }
            }
    }
};

struct EpiOut {
    float* out; unsigned char* ws; const float* x_prompt; const float* x_sample;
    __device__ __forceinline__ void operator()(const f32x4 (&acc)[2][2][4][2], const pg8::Unit& u, int wr, int wc, int fr, int fq) const {
        const int pn = u.pn, lc0 = wc * 32 + fq * 8; const float* MOD = (const float*)(ws + WS_MOD); float* RSQ = (float*)(ws + WS_RSQ);
#pragma unroll
        for (int ai = 0; ai < 2; ++ai)
#pragma unroll
            for (int m = 0; m < 4; ++m) {
                const int row = u.pm * 256 + ai * 128 + wr * 64 + m * 16 + fr;
                const bool valid = row < NPR + NSR; float ss = 0.f;
                if (valid) {
                    const float* xr; float* yr; int mr;
                    if (row < NPR) { xr = x_prompt + (size_t)row * DM; yr = out + O_YP + (size_t)row * DM; mr = row >> 13; }
                    else { xr = x_sample + (size_t)(row - NPR) * DM; yr = out + O_YS + (size_t)(row - NPR) * DM; mr = 4 + ((row - NPR) >> 2); }
                    const float* gate = MOD + (size_t)mr * 3072 + 2048;
#pragma unroll
                    for (int bj = 0; bj < 2; ++bj)
#pragma unroll
                        for (int n = 0; n < 2; ++n) { const int c = 256 * pn + 128 * bj + lc0 + 4 * n;
                            const f32x4 o = *(const f32x4*)(xr + c) + *(const f32x4*)(gate + c) * acc[ai][bj][m][n];
                            ss += (o.x * o.x + o.y * o.y) + (o.z * o.z + o.w * o.w);
                            *(f32x4*)(yr + c) = o; }
                }
                ss += __shfl_xor(ss, 16); ss += __shfl_xor(ss, 32);
                if (valid && fq == 0) RSQ[(size_t)row * 16 + pn * 4 + wc] = ss;
            }
    }
};

__device__ __forceinline__ void p5_rows(const Args& a, Frame& F) {
    const float* RSQ = (const float*)(a.ws + WS_RSQ);
    const int gw = F.bid * 8 + F.wave, NGW = F.G * 8;
    for (int row = gw; row < NPR + NSR; row += NGW) {
        float s = (F.lane < 16) ? RSQ[(size_t)row * 16 + F.lane] : 0.f;
        s = wave_sum(s);
        const float rstd = 1.f / sqrtf(s * (1.f / DM) + EPS);
        f32x4* y4 = (f32x4*)(row < NPR ? a.out + O_YP + (size_t)row * DM : a.out + O_YS + (size_t)(row - NPR) * DM) + F.lane;
#pragma unroll
        for (int j = 0; j < 4; ++j) { const f32x4 g = *((const f32x4*)a.final_g + F.lane + 64 * j); y4[64 * j] = y4[64 * j] * rstd * g; }
    }
}

__device__ __forceinline__ void conv_rows(const Args& a, Frame& F) {
    const bf16_t* U = (const bf16_t*)(a.ws + WS_U); const bf16_t* BCZ = (const bf16_t*)(a.ws + WS_BCZ); bf16_t* A2 = (bf16_t*)(a.ws + WS_A2);
    const size_t total = (size_t)(NPR + NSR) * 128;
    for (size_t i = (size_t)F.bid * 512 + F.tid; i < total; i += (size_t)F.G * 512) {
        const int row = (int)(i >> 7), c = (int)(i & 127) * 8;
        float um2[8], um1[8], u0[8], bz[8];
        { const u32x4 w = *(const u32x4*)(U + (size_t)row * DM + c); u0[0] = bflo(w.x); u0[1] = bfhi(w.x); u0[2] = bflo(w.y); u0[3] = bfhi(w.y); u0[4] = bflo(w.z); u0[5] = bfhi(w.z); u0[6] = bflo(w.w); u0[7] = bfhi(w.w); }
        { const u32x4 w = *(const u32x4*)(BCZ + (size_t)row * DM + c); bz[0] = bflo(w.x); bz[1] = bfhi(w.x); bz[2] = bflo(w.y); bz[3] = bfhi(w.y); bz[4] = bflo(w.z); bz[5] = bfhi(w.z); bz[6] = bflo(w.w); bz[7] = bfhi(w.w); }
        int t; const float* st = nullptr;
        if (row < NPR) t = row & (SEQ - 1); else { t = (row - NPR) & 3; st = a.state_conv + (size_t)((row - NPR) >> 2) * 2 * 1024 + c; }
        if (t >= 1) { const u32x4 w = *(const u32x4*)(U + (size_t)(row - 1) * DM + c); um1[0] = bflo(w.x); um1[1] = bfhi(w.x); um1[2] = bflo(w.y); um1[3] = bfhi(w.y); um1[4] = bflo(w.z); um1[5] = bfhi(w.z); um1[6] = bflo(w.w); um1[7] = bfhi(w.w); }
        else if (st) {
#pragma unroll
            for (int j = 0; j < 8; ++j) um1[j] = st[1024 + j]; }
        else {
#pragma unroll
            for (int j = 0; j < 8; ++j) um1[j] = 0.f; }
        if (t >= 2) { const u32x4 w = *(const u32x4*)(U + (size_t)(row - 2) * DM + c); um2[0] = bflo(w.x); um2[1] = bfhi(w.x); um2[2] = bflo(w.y); um2[3] = bfhi(w.y); um2[4] = bflo(w.z); um2[5] = bfhi(w.z); um2[6] = bflo(w.w); um2[7] = bfhi(w.w); }
        else if (st) {
#pragma unroll
            for (int j = 0; j < 8; ++j) um2[j] = st[(t == 1 ? 1024 : 0) + j]; }
        else {
#pragma unroll
            for (int j = 0; j < 8; ++j) um2[j] = 0.f; }
        float r[8];
#pragma unroll
        for (int j = 0; j < 8; ++j) r[j] = (a.conv_w[c + j] * um2[j] + a.conv_w[1024 + c + j] * um1[j] + a.conv_w[2048 + c + j] * u0[j]) * bz[j];
        u32x4 o; o.x = pk_bf16(r[0], r[1]); o.y = pk_bf16(r[2], r[3]); o.z = pk_bf16(r[4], r[5]); o.w = pk_bf16(r[6], r[7]);
        *(u32x4*)(A2 + (size_t)row * DMIX + 1024 + c) = o;
    }
}
__device__ __forceinline__ void a2_zero_pad(const Args& a, Frame& F) {
    bf16_t* A2 = (bf16_t*)(a.ws + WS_A2) + (size_t)(NPR + NSR) * DMIX;
    const size_t total = (size_t)(MROWS - NPR - NSR) * DMIX / 8;
    for (size_t i = (size_t)F.bid * 512 + F.tid; i < total; i += (size_t)F.G * 512) *(u32x4*)(A2 + i * 8) = (u32x4){0u, 0u, 0u, 0u};
}

template <int MODE> __device__ __forceinline__ void compress_unit(const Args& a, Frame& F, int kv, int tl) {
    LAS unsigned char* L = F.lds;
    constexpr int PITCH = 72, STG = 128 * PITCH * 2;
    const int tid = F.tid, lane = F.lane, w = F.wave, r16 = lane & 15, kq = lane >> 4;
    const int R = tid >> 2, c4 = tid & 3;
    const float* srcf = nullptr; const bf16_t* srcb = nullptr;
    if (MODE == 0) { const int sb = tl >> 2, blk = (tl & 3) * 64 + (R >> 1), g = R & 1; const int page = a.page_table[sb * 128 + (blk >> 1)];
        srcf = (kv ? a.cache_v_cmp : a.cache_k_cmp) + (((size_t)page * 128 + (blk & 1) * 64) * 2 + g) * 64 + c4 * 16; }
    else { const int GR = tl * 128 + R, bblk = GR >> 1, g = GR & 1, b = bblk >> 7, blk = bblk & 127;
        srcb = (const bf16_t*)(a.ws + (kv ? WS_VC : WS_KC)) + ((size_t)(b * SEQ + blk * 64)) * 128 + g * 64 + c4 * 16; }
    const bf16_t* wsrc = (const bf16_t*)(a.ws + WS_W1T) + (size_t)kv * 128 * 4096 + (size_t)R * 4096 + c4 * 16;
    const int wm = w >> 1, wn = w & 1;
    f32x4 acc[2][4];
#pragma unroll
    for (int i = 0; i < 2; ++i)
#pragma unroll
        for (int j = 0; j < 4; ++j) acc[i][j] = (f32x4){0.f, 0.f, 0.f, 0.f};
    u32x4 ra[2], rb[2];
    auto load = [&](int ks) {
        if (MODE == 0) { const f32x4* p = (const f32x4*)(srcf + (size_t)ks * 128); const f32x4 v0 = p[0], v1 = p[1], v2 = p[2], v3 = p[3];
            ra[0] = (u32x4){pk_bf16(v0.x, v0.y), pk_bf16(v0.z, v0.w), pk_bf16(v1.x, v1.y), pk_bf16(v1.z, v1.w)};
            ra[1] = (u32x4){pk_bf16(v2.x, v2.y), pk_bf16(v2.z, v2.w), pk_bf16(v3.x, v3.y), pk_bf16(v3.z, v3.w)}; }
        else { const u32x4* p = (const u32x4*)(srcb + (size_t)ks * 128); ra[0] = p[0]; ra[1] = p[1]; }
        const u32x4* q = (const u32x4*)(wsrc + ks * 64); rb[0] = q[0]; rb[1] = q[1];
    };
    auto store = [&](int st) {
        LAS unsigned char* pa = L + st * STG + (R * PITCH + c4 * 16) * 2; LAS unsigned char* pb = L + 2 * STG + st * STG + (R * PITCH + c4 * 16) * 2;
        *(LAS u32x4*)pa = ra[0]; *(LAS u32x4*)(pa + 16) = ra[1]; *(LAS u32x4*)pb = rb[0]; *(LAS u32x4*)(pb + 16) = rb[1];
    };
    load(0); store(0); __syncthreads();
    for (int ks = 0; ks < 64; ++ks) {
        const int st = ks & 1;
        if (ks + 1 < 64) load(ks + 1);
        LAS const unsigned char* As = L + st * STG; LAS const unsigned char* Bs = L + 2 * STG + st * STG;
#pragma unroll
        for (int s = 0; s < 2; ++s) {
            bf16x8 af[2], bfr[4];
#pragma unroll
            for (int mi = 0; mi < 2; ++mi) af[mi] = *(const LAS bf16x8*)(As + ((32 * wm + 16 * mi + r16) * PITCH + 32 * s + 8 * kq) * 2);
#pragma unroll
            for (int ni = 0; ni < 4; ++ni) bfr[ni] = *(const LAS bf16x8*)(Bs + ((64 * wn + 16 * ni + r16) * PITCH + 32 * s + 8 * kq) * 2);
#pragma unroll
            for (int mi = 0; mi < 2; ++mi)
#pragma unroll
                for (int ni = 0; ni < 4; ++ni) acc[mi][ni] = __builtin_amdgcn_mfma_f32_16x16x32_bf16(af[mi], bfr[ni], acc[mi][ni], 0, 0, 0);
        }
        if (ks + 1 < 64) store(st ^ 1);
        __syncthreads();
    }
    LAS float* HID = (LAS float*)L; LAS float* W2s = (LAS float*)(L + 67584);
    const float* b1 = (const float*)(a.ws + WS_B1) + kv * 128;
#pragma unroll
    for (int mi = 0; mi < 2; ++mi)
#pragma unroll
        for (int ni = 0; ni < 4; ++ni) { const int col = 64 * wn + 16 * ni + r16; const float bb = b1[col];
#pragma unroll
            for (int r = 0; r < 4; ++r) HID[(32 * wm + 16 * mi + 4 * kq + r) * 132 + col] = siluf_(acc[mi][ni][r] + bb); }
    { const f32x4* w2 = (const f32x4*)(kv ? a.cmp_w2_v : a.cmp_w2_k);
#pragma unroll
      for (int i = 0; i < 4; ++i) ((LAS f32x4*)W2s)[tid + 512 * i] = w2[tid + 512 * i]; }
    __syncthreads();
    {
        float o[16];
#pragma unroll
        for (int j = 0; j < 16; ++j) o[j] = 0.f;
        for (int n = 0; n < 128; ++n) { const float h = HID[R * 132 + n]; const LAS f32x4* wr = (const LAS f32x4*)(W2s + n * 64 + c4 * 16);
#pragma unroll
            for (int q = 0; q < 4; ++q) { const f32x4 wv = wr[q]; o[4 * q] += h * wv.x; o[4 * q + 1] += h * wv.y; o[4 * q + 2] += h * wv.z; o[4 * q + 3] += h * wv.w; } }
        if (MODE == 0) { const int sb = tl >> 2, blk = (tl & 3) * 64 + (R >> 1), g = R & 1;
            float* d = (float*)(a.ws + (kv ? WS_VCMPS : WS_KCMPS)) + ((size_t)(sb * 2 + g) * 256 + blk) * 64 + c4 * 16;
#pragma unroll
            for (int q = 0; q < 4; ++q) *(f32x4*)(d + 4 * q) = (f32x4){o[4 * q], o[4 * q + 1], o[4 * q + 2], o[4 * q + 3]}; }
        else { const int GR = tl * 128 + R, bblk = GR >> 1, g = GR & 1, b = bblk >> 7, blk = bblk & 127;
            if (kv == 0) { bf16_t* d = (bf16_t*)(a.ws + WS_KCMPP) + ((size_t)(b * 2 + g) * 128 + blk) * 64 + c4 * 16;
                *(u32x4*)d = (u32x4){pk_bf16(o[0], o[1]), pk_bf16(o[2], o[3]), pk_bf16(o[4], o[5]), pk_bf16(o[6], o[7])};
                *(u32x4*)(d + 8) = (u32x4){pk_bf16(o[8], o[9]), pk_bf16(o[10], o[11]), pk_bf16(o[12], o[13]), pk_bf16(o[14], o[15])}; }
            else { bf16_t* d = (bf16_t*)(a.ws + WS_VCMPT) + ((size_t)(b * 2 + g) * 64 + c4 * 16) * 128 + (blk & ~31) + vslot32(blk & 31);
#pragma unroll
                for (int j = 0; j < 16; ++j) d[(size_t)j * 128] = (bf16_t)(pk_bf16(o[j], 0.f) & 0xffffu); } }
    }
    __syncthreads();
}

__device__ __forceinline__ int swz_off(int row, int chunk) { return row * 128 + ((chunk ^ (row & 7)) << 4); }
struct TileRegs { u32x4 k, v; };
__device__ __forceinline__ void tile_fetch(TileRegs& t, const bf16_t* Kbg, const bf16_t* Vtbg, int j, int tid) {
    t.k = *(const u32x4*)(Kbg + (size_t)(64 * j + (tid >> 3)) * 128 + (tid & 7) * 8);
    t.v = *(const u32x4*)(Vtbg + (size_t)j * 4096 + tid * 8);
}
__device__ __forceinline__ void tile_store(const TileRegs& t, LAS unsigned char* stage, int tid) {
    const int off = swz_off(tid >> 3, tid & 7);
    *(LAS u32x4*)(stage + off) = t.k; *(LAS u32x4*)(stage + 8192 + off) = t.v;
}
template <bool NEAR>
__device__ __forceinline__ void pair_tile(f32x4 (&O)[4], float& mrun, float& lrun, const bf16x8 (&Qf)[2], LAS const unsigned char* Kt, LAS const unsigned char* Vt,
                                          LAS const float* BTl, int r16, int kq, bool colsel, int kmin, int kmax, int dbase, int hh, float bfar) {
    f32x4 S[4];
#pragma unroll
    for (int m = 0; m < 4; ++m) { S[m] = (f32x4){0.f, 0.f, 0.f, 0.f};
#pragma unroll
        for (int s = 0; s < 2; ++s) { const bf16x8 kf = *(const LAS bf16x8*)(Kt + swz_off(16 * m + r16, 4 * s + kq)); S[m] = __builtin_amdgcn_mfma_f32_16x16x32_bf16(kf, Qf[s], S[m], 0, 0, 0); } }
    float mx = NEG_INF;
#pragma unroll
    for (int m = 0; m < 4; ++m)
#pragma unroll
        for (int r = 0; r < 4; ++r) { const int kidx = 16 * m + 4 * kq + r; const bool ok = colsel && kidx >= kmin && kidx <= kmax; float bias = bfar;
            if (NEAR) { int d = dbase - kidx; d = d < 0 ? 0 : (d > 128 ? 128 : d); bias = BTl[d * 16 + hh]; }
            const float v = ok ? S[m][r] + bias : NEG_INF; S[m][r] = v; mx = fmaxf(mx, v); }
    mx = fmaxf(mx, __shfl_xor(mx, 16)); mx = fmaxf(mx, __shfl_xor(mx, 32));
    const float mnew = fmaxf(mrun, mx), msafe = (mnew == NEG_INF) ? 0.f : mnew;
    const float alpha = fexp2(mrun - msafe);
    float ps = 0.f;
#pragma unroll
    for (int m = 0; m < 4; ++m)
#pragma unroll
        for (int r = 0; r < 4; ++r) { const float p = fexp2(S[m][r] - msafe); S[m][r] = p; ps += p; }
    lrun = lrun * alpha + ps; mrun = mnew;
#pragma unroll
    for (int md = 0; md < 4; ++md) O[md] = O[md] * alpha;
    bf16x8 Pf[2];
#pragma unroll
    for (int s = 0; s < 2; ++s) { const u32x4 w = (u32x4){pk_bf16(S[2 * s][0], S[2 * s][1]), pk_bf16(S[2 * s][2], S[2 * s][3]), pk_bf16(S[2 * s + 1][0], S[2 * s + 1][1]), pk_bf16(S[2 * s + 1][2], S[2 * s + 1][3])};
        Pf[s] = __builtin_bit_cast(bf16x8, w); }
#pragma unroll
    for (int md = 0; md < 4; ++md)
#pragma unroll
        for (int s = 0; s < 2; ++s) { const bf16x8 vf = *(const LAS bf16x8*)(Vt + swz_off(16 * md + r16, 4 * s + kq)); O[md] = __builtin_amdgcn_mfma_f32_16x16x32_bf16(vf, Pf[s], O[md], 0, 0, 0); }
}

constexpr int AT_RING = 0;
constexpr int AT_KCMP = 32768;
constexpr int AT_VCMP = 49152;
constexpr int AT_SCORE = 65536;
constexpr int AT_BT = 131072;
constexpr int AT_END = AT_BT + 8448;

__device__ __forceinline__ void load_bt(const Args& a, Frame& F, int off) {
    const float* BT = (const float*)(a.ws + WS_BT); LAS float* d = (LAS float*)(F.lds + off);
    for (int i = F.tid; i < 129 * 16; i += 512) d[i] = BT[i];
}

__device__ __forceinline__ void win_unit(const Args& a, Frame& F, int b, int g, int qb) {
    LAS unsigned char* L = F.lds; const int tid = F.tid, lane = F.lane, w = F.wave, r16 = lane & 15, kq = lane >> 4, slot = r16 >> 3, h = r16 & 7, hh = g * 8 + h;
    const bf16_t* Kbg = (const bf16_t*)(a.ws + WS_KW) + (size_t)b * SEQ * 128 + g * 64;
    const bf16_t* Vtbg = (const bf16_t*)(a.ws + WS_VWT) + (size_t)(b * 2 + g) * 128 * 4096;
    const bf16_t* Qb = (const bf16_t*)(a.ws + WS_Q);
    LAS const float* BTl = (LAS const float*)(L + AT_BT);
    const int j0 = qb >= 8 ? qb - 8 : 0;
    TileRegs tr; tile_fetch(tr, Kbg, Vtbg, j0, tid);
    load_bt(a, F, AT_BT);
    bf16x8 Qf[4][2];
#pragma unroll
    for (int p = 0; p < 4; ++p) { const int q = qb * 64 + w * 8 + 2 * p + slot; const bf16_t* qp = Qb + ((size_t)(b * SEQ + q)) * DM + g * 512 + h * 64 + 8 * kq;
        Qf[p][0] = *(const bf16x8*)qp; Qf[p][1] = *(const bf16x8*)(qp + 32); }
    tile_store(tr, L + AT_RING, tid);
    __syncthreads();
    f32x4 O[4][4]; float mr[4], lr[4];
#pragma unroll
    for (int p = 0; p < 4; ++p) { mr[p] = NEG_INF; lr[p] = 0.f;
#pragma unroll
        for (int md = 0; md < 4; ++md) O[p][md] = (f32x4){0.f, 0.f, 0.f, 0.f}; }
    const float bfar = BTl[128 * 16 + hh];
for (int j = j0; j <= qb; ++j) {
        const int st = (j - j0) & 1;
        if (j < qb) tile_fetch(tr, Kbg, Vtbg, j + 1, tid);
        LAS const unsigned char* Kt = L + AT_RING + st * 16384; LAS const unsigned char* Vt = Kt + 8192;
        const bool near = j + 2 >= qb;
#pragma unroll
        for (int p = 0; p < 4; ++p) { const int i = w * 8 + 2 * p + slot;
            const int kmax = (j == qb) ? i : 63, kmin = (j + 8 == qb) ? i : 0, dbase = 64 * (qb - j) + i;
            if (near) pair_tile<true>(O[p], mr[p], lr[p], Qf[p], Kt, Vt, BTl, r16, kq, true, kmin, kmax, dbase, hh, bfar);
            else pair_tile<false>(O[p], mr[p], lr[p], Qf[p], Kt, Vt, BTl, r16, kq, true, kmin, kmax, dbase, hh, bfar); }
        if (j < qb) tile_store(tr, L + AT_RING + (st ^ 1) * 16384, tid);
        __syncthreads();
    }
    bf16_t* OW = (bf16_t*)(a.ws + WS_OWIN);
#pragma unroll
    for (int p = 0; p < 4; ++p) { float lt = lr[p]; lt += __shfl_xor(lt, 16); lt += __shfl_xor(lt, 32); const float inv = lt > 0.f ? 1.f / lt : 0.f;
        const int q = qb * 64 + w * 8 + 2 * p + slot; bf16_t* d = OW + ((size_t)(b * SEQ + q)) * DM + g * 512 + h * 64 + 4 * kq;
#pragma unroll
        for (int md = 0; md < 4; ++md) { const f32x4 o = O[p][md] * inv; *(u32x2*)(d + 16 * md) = (u32x2){pk_bf16(o.x, o.y), pk_bf16(o.z, o.w)}; } }
}

template <int NE> __device__ __forceinline__ void topk16(const unsigned (&key)[NE], unsigned long long (&sel)[NE], int lane) {
    unsigned T = 0u;
    for (int bit = 31; bit >= 0; --bit) { const unsigned cand = T | (1u << bit); int cnt = 0;
#pragma unroll
        for (int e = 0; e < NE; ++e) cnt += __popcll(__ballot(key[e] >= cand));
        if (cnt >= 16) T = cand; }
    if (T == 0u) {
#pragma unroll
        for (int e = 0; e < NE; ++e) sel[e] = __ballot(key[e] > 0u);
        return; }
    int ngt = 0;
#pragma unroll
    for (int e = 0; e < NE; ++e) ngt += __popcll(__ballot(key[e] > T));
    int need = 16 - ngt, prior = 0; const unsigned long long lt = (1ull << lane) - 1ull;
#pragma unroll
    for (int e = 0; e < NE; ++e) { const bool eq = key[e] == T; const unsigned long long em = __ballot(eq); const int rank = prior + __popcll(em & lt);
        sel[e] = __ballot(key[e] > T || (eq && rank < need)); prior += __popcll(em); }
}

__device__ __forceinline__ void nsa_unit(const Args& a, Frame& F, int b, int g, int qb) {
    LAS unsigned char* L = F.lds; const int tid = F.tid, lane = F.lane, w = F.wave, r16 = lane & 15, kq = lane >> 4, slot = r16 >> 3, h = r16 & 7, hh = g * 8 + h;
    const bf16_t* Kbg = (const bf16_t*)(a.ws + WS_KSL) + (size_t)b * SEQ * 128 + g * 64;
    const bf16_t* Vtbg = (const bf16_t*)(a.ws + WS_VSLT) + (size_t)(b * 2 + g) * 128 * 4096;
    const bf16_t* Qb = (const bf16_t*)(a.ws + WS_Q);
    LAS const float* BTl = (LAS const float*)(L + AT_BT);
    LAS float* SCORE = (LAS float*)(L + AT_SCORE);
    TileRegs tr; tile_fetch(tr, Kbg, Vtbg, 0, tid);
    { const u32x4* ks = (const u32x4*)((const bf16_t*)(a.ws + WS_KCMPP) + (size_t)(b * 2 + g) * 128 * 64);
      const u32x4* vs = (const u32x4*)((const bf16_t*)(a.ws + WS_VCMPT) + (size_t)(b * 2 + g) * 64 * 128);
#pragma unroll
      for (int i = 0; i < 2; ++i) { const int c = tid + 512 * i;
          *(LAS u32x4*)(L + AT_KCMP + swz_off(c >> 3, c & 7)) = ks[c];
          const int row = c >> 4, ch = c & 15; *(LAS u32x4*)(L + AT_VCMP + row * 256 + (((ch & 8) | ((ch ^ row) & 7)) << 4)) = vs[c]; } }
    load_bt(a, F, AT_BT);
    bf16x8 Qf[4][2];
#pragma unroll
    for (int p = 0; p < 4; ++p) { const int q = qb * 64 + w * 8 + 2 * p + slot; const bf16_t* qp = Qb + ((size_t)(b * SEQ + q)) * DM + g * 512 + h * 64 + 8 * kq;
        Qf[p][0] = *(const bf16x8*)qp; Qf[p][1] = *(const bf16x8*)(qp + 32); }
    tile_store(tr, L + AT_RING, tid);
    __syncthreads();
    const float bfar = BTl[128 * 16 + hh];
    const float* Gt = (const float*)(a.ws + WS_G);
    bf16_t* A2 = (bf16_t*)(a.ws + WS_A2);
    const int nmt = (qb + 16) >> 4;
#pragma unroll
    for (int p = 0; p < 4; ++p) {
        const int i = w * 8 + 2 * p + slot, q = qb * 64 + i;
        f32x4 S[8]; float mx = NEG_INF;
#pragma unroll
        for (int m = 0; m < 8; ++m) { S[m] = (f32x4){NEG_INF, NEG_INF, NEG_INF, NEG_INF};
            if (m < nmt) { f32x4 c = (f32x4){0.f, 0.f, 0.f, 0.f};
#pragma unroll
                for (int s = 0; s < 2; ++s) { const bf16x8 kf = *(const LAS bf16x8*)(L + AT_KCMP + swz_off(16 * m + r16, 4 * s + kq)); c = __builtin_amdgcn_mfma_f32_16x16x32_bf16(kf, Qf[p][s], c, 0, 0, 0); }
#pragma unroll
                for (int r = 0; r < 4; ++r) { const int jb = 16 * m + 4 * kq + r; const bool vis = (jb < qb) || (jb == qb && i == 63);
                    int d = 64 * (qb - jb) + i - 63; d = d < 0 ? 0 : (d > 128 ? 128 : d);
                    const float v = vis ? c[r] + BTl[d * 16 + hh] : NEG_INF; S[m][r] = v; mx = fmaxf(mx, v); } } }
        mx = fmaxf(mx, __shfl_xor(mx, 16)); mx = fmaxf(mx, __shfl_xor(mx, 32));
        const float msafe = (mx == NEG_INF) ? 0.f : mx; float ps = 0.f;
#pragma unroll
        for (int m = 0; m < 8; ++m)
#pragma unroll
            for (int r = 0; r < 4; ++r) { const float pp = fexp2(S[m][r] - msafe); S[m][r] = pp; ps += pp; }
        ps += __shfl_xor(ps, 16); ps += __shfl_xor(ps, 32);
        const float inv = ps > 0.f ? 1.f / ps : 0.f;
#pragma unroll
        for (int m = 0; m < 8; ++m) { f32x4 pn = S[m] * inv; S[m] = pn;
            f32x4 im = pn;
#pragma unroll
            for (int r = 0; r < 4; ++r) { float v = im[r]; v += __shfl_xor(v, 1); v += __shfl_xor(v, 2); v += __shfl_xor(v, 4); im[r] = v; }
#pragma unroll
            for (int r = 0; r < 4; ++r) { const int jb = 16 * m + 4 * kq + r; const bool vis = (jb < qb) || (jb == qb && i == 63);
                im[r] = vis ? im[r] : (jb <= qb ? 2.0f : -1.0f); }
            if (h == 0) *(LAS f32x4*)(SCORE + i * 256 + 16 * m + 4 * kq) = im; }
        f32x4 oc[4];
#pragma unroll
        for (int md = 0; md < 4; ++md) oc[md] = (f32x4){0.f, 0.f, 0.f, 0.f};
#pragma unroll
        for (int s = 0; s < 4; ++s) if (2 * s < nmt) {
            const u32x4 wv = (u32x4){pk_bf16(S[2 * s][0], S[2 * s][1]), pk_bf16(S[2 * s][2], S[2 * s][3]), pk_bf16(S[2 * s + 1][0], S[2 * s + 1][1]), pk_bf16(S[2 * s + 1][2], S[2 * s + 1][3])};
            const bf16x8 pf = __builtin_bit_cast(bf16x8, wv);
#pragma unroll
            for (int md = 0; md < 4; ++md) { const int row = 16 * md + r16, ch = 4 * s + kq;
                const bf16x8 vf = *(const LAS bf16x8*)(L + AT_VCMP + row * 256 + (((ch & 8) | ((ch ^ row) & 7)) << 4));
                oc[md] = __builtin_amdgcn_mfma_f32_16x16x32_bf16(vf, pf, oc[md], 0, 0, 0); } }
        const float g0 = Gt[(size_t)(b * SEQ + q) * 48 + hh];
#pragma unroll
        for (int md = 0; md < 4; ++md) { const f32x4 o = oc[md] * g0;
            *(u32x2*)(A2 + (size_t)(b * SEQ + q) * DMIX + g * 512 + h * 64 + 4 * kq + 16 * md) = (u32x2){pk_bf16(o.x, o.y), pk_bf16(o.z, o.w)}; }
    }
    LDS_WAIT(); __builtin_amdgcn_wave_barrier(); asm volatile("" ::: "memory");
    unsigned long long mA[8], mB[8];
#pragma unroll
    for (int qq = 0; qq < 8; ++qq) { const int i = w * 8 + qq; const float sa = SCORE[i * 256 + lane], sb = SCORE[i * 256 + 64 + lane];
        unsigned key[2]; key[0] = sa >= 0.f ? __float_as_uint(sa) + 1u : 0u; key[1] = sb >= 0.f ? __float_as_uint(sb) + 1u : 0u;
        unsigned long long sel[2]; topk16<2>(key, sel, lane); mA[qq] = sel[0]; mB[qq] = sel[1]; }
    LDS_WAIT(); __builtin_amdgcn_wave_barrier(); asm volatile("" ::: "memory");
    LAS bf16x8* QL = (LAS bf16x8*)(L + AT_SCORE + w * 8192) + lane;
#pragma unroll
    for (int p = 0; p < 4; ++p) { QL[(p * 2) * 64] = Qf[p][0]; QL[(p * 2 + 1) * 64] = Qf[p][1]; }
    LDS_WAIT(); asm volatile("" ::: "memory");
    f32x4 O[4][4]; float mr[4], lr[4];
#pragma unroll
    for (int p = 0; p < 4; ++p) { mr[p] = NEG_INF; lr[p] = 0.f;
#pragma unroll
        for (int md = 0; md < 4; ++md) O[p][md] = (f32x4){0.f, 0.f, 0.f, 0.f}; }
for (int j = 0; j <= qb; ++j) {
        const int st = j & 1;
        if (j < qb) tile_fetch(tr, Kbg, Vtbg, j + 1, tid);
        LAS const unsigned char* Kt = L + AT_RING + st * 16384; LAS const unsigned char* Vt = Kt + 8192;
        const bool near = j + 2 >= qb;
#pragma unroll
        for (int p = 0; p < 4; ++p) {
            const bool a0 = (((j < 64 ? mA[2 * p] : mB[2 * p]) >> (j & 63)) & 1ull) != 0ull, a1 = (((j < 64 ? mA[2 * p + 1] : mB[2 * p + 1]) >> (j & 63)) & 1ull) != 0ull;
            if (a0 || a1) { const int i = w * 8 + 2 * p + slot; const bool colsel = slot ? a1 : a0;
                const int kmax = (j == qb) ? i : 63, dbase = 64 * (qb - j) + i;
                bf16x8 qf[2]; qf[0] = QL[(p * 2) * 64]; qf[1] = QL[(p * 2 + 1) * 64];
                pair_tile<true>(O[p], mr[p], lr[p], qf, Kt, Vt, BTl, r16, kq, colsel, 0, kmax, dbase, hh, bfar); } }
        if (j < qb) tile_store(tr, L + AT_RING + (st ^ 1) * 16384, tid);
        __syncthreads();
    }
    const bf16_t* OW = (const bf16_t*)(a.ws + WS_OWIN); const bf16_t* SZ = (const bf16_t*)(a.ws + WS_SZA);
#pragma unroll
    for (int p = 0; p < 4; ++p) { float lt = lr[p]; lt += __shfl_xor(lt, 16); lt += __shfl_xor(lt, 32);
        const int q = qb * 64 + w * 8 + 2 * p + slot; const size_t row = (size_t)(b * SEQ + q);
        const float g1 = Gt[row * 48 + 16 + hh], g2 = Gt[row * 48 + 32 + hh]; const float inv = lt > 0.f ? g1 / lt : 0.f;
        const int col = g * 512 + h * 64 + 4 * kq;
#pragma unroll
        for (int md = 0; md < 4; ++md) { const u32x2 ow = *(const u32x2*)(OW + row * DM + col + 16 * md), sz = *(const u32x2*)(SZ + row * DM + col + 16 * md);
            const u32x2 ocv = __builtin_nontemporal_load((const u32x2*)(A2 + row * DMIX + col + 16 * md));
            const f32x4 o = (f32x4){bflo(ocv.x), bfhi(ocv.x), bflo(ocv.y), bfhi(ocv.y)} + O[p][md] * inv + (f32x4){bflo(ow.x), bfhi(ow.x), bflo(ow.y), bfhi(ow.y)} * g2;
            const f32x4 r = o * (f32x4){bflo(sz.x), bfhi(sz.x), bflo(sz.y), bfhi(sz.y)};
            *(u32x2*)(A2 + row * DMIX + col + 16 * md) = (u32x2){pk_bf16(r.x, r.y), pk_bf16(r.z, r.w)}; } }
}

constexpr int SU_KT = 0, SU_VT = 17408, SU_QS = 34816, SU_PW = 36864, SU_IMP = 38912, SU_BT = 47360, SU_SEL = 55616, SU_SCORE = 55808;
struct VSrc { const float* k; const float* v; bool ok; };
__device__ __forceinline__ float valu_tile(LAS const float* KT, LAS const float* VT, LAS const float* QSh, LAS float* PWh, int lane, bool ok, float bias, float& m, float& l, float& O) {
    float s = 0.f;
#pragma unroll 4
    for (int d4 = 0; d4 < 16; ++d4) { const f32x4 kk = *(const LAS f32x4*)(KT + lane * 68 + 4 * d4), qq = *(const LAS f32x4*)(QSh + 4 * d4); s += kk.x * qq.x + kk.y * qq.y + kk.z * qq.z + kk.w * qq.w; }
    s = ok ? s + bias : NEG_INF;
    const float mt = wave_max(s), mnew = fmaxf(m, mt), msafe = (mnew == NEG_INF) ? 0.f : mnew;
    const float alpha = fexp2(m - msafe), p = fexp2(s - msafe);
    l = l * alpha + wave_sum(p); m = mnew;
    PWh[lane] = p; LDS_WAIT(); __builtin_amdgcn_wave_barrier();
    float o = O * alpha;
#pragma unroll 4
    for (int k4 = 0; k4 < 16; ++k4) { const f32x4 pp = *(const LAS f32x4*)(PWh + 4 * k4);
        o += pp.x * VT[(4 * k4) * 68 + lane] + pp.y * VT[(4 * k4 + 1) * 68 + lane] + pp.z * VT[(4 * k4 + 2) * 68 + lane] + pp.w * VT[(4 * k4 + 3) * 68 + lane]; }
    O = o; LDS_WAIT(); __builtin_amdgcn_wave_barrier();
    return s;
}
struct VRegs { f32x4 k0, k1, v0, v1; };
__device__ __forceinline__ void vfetch(VRegs& r, const VSrc& s) {
    if (s.ok) { const f32x4* kp = (const f32x4*)s.k; const f32x4* vp = (const f32x4*)s.v; r.k0 = kp[0]; r.k1 = kp[1]; r.v0 = vp[0]; r.v1 = vp[1]; }
    else { r.k0 = r.k1 = r.v0 = r.v1 = (f32x4){0.f, 0.f, 0.f, 0.f}; }
}
__device__ __forceinline__ void vstore(const VRegs& r, LAS unsigned char* L, int tid) {
    LAS float* kd = (LAS float*)(L + SU_KT) + (tid >> 3) * 68 + (tid & 7) * 8; LAS float* vd = (LAS float*)(L + SU_VT) + (tid >> 3) * 68 + (tid & 7) * 8;
    *(LAS f32x4*)kd = r.k0; *(LAS f32x4*)(kd + 4) = r.k1; *(LAS f32x4*)vd = r.v0; *(LAS f32x4*)(vd + 4) = r.v1;
}
__device__ __forceinline__ void sample_unit(const Args& a, Frame& F, int sb, int g, int t) {
    LAS unsigned char* L = F.lds; const int tid = F.tid, lane = F.lane, h = F.wave, hh = g * 8 + h, key = tid >> 3, c8 = tid & 7;
    const int qpos = PAST + t; const size_t row = (size_t)NPR + sb * 4 + t;
    LAS float* QSh = (LAS float*)(L + SU_QS) + h * 64; LAS float* PWh = (LAS float*)(L + SU_PW) + h * 64; LAS float* IMP = (LAS float*)(L + SU_IMP);
    LAS const float* BTl = (LAS const float*)(L + SU_BT); LAS int* SEL = (LAS int*)(L + SU_SEL); LAS float* SCORE = (LAS float*)(L + SU_SCORE);
    LAS const float* KT = (LAS const float*)(L + SU_KT); LAS const float* VT = (LAS const float*)(L + SU_VT);
    load_bt(a, F, SU_BT);
    QSh[lane] = bf2f(((const bf16_t*)(a.ws + WS_Q))[row * DM + g * 512 + h * 64 + lane]);
    VRegs vr; VSrc src;
    const float* kc = (const float*)(a.ws + WS_KCMPS) + (size_t)(sb * 2 + g) * 256 * 64; const float* vc = (const float*)(a.ws + WS_VCMPS) + (size_t)(sb * 2 + g) * 256 * 64;
    float mc = NEG_INF, lc = 0.f, oc = 0.f, sc[4];
    src.k = kc + (size_t)key * 64 + c8 * 8; src.v = vc + (size_t)key * 64 + c8 * 8; src.ok = true; vfetch(vr, src);
    __syncthreads();
#pragma unroll
    for (int tl = 0; tl < 4; ++tl) {
        vstore(vr, L, tid); __syncthreads();
        if (tl < 3) { src.k = kc + (size_t)(64 * (tl + 1) + key) * 64 + c8 * 8; src.v = vc + (size_t)(64 * (tl + 1) + key) * 64 + c8 * 8; vfetch(vr, src); }
        int d = qpos - (64 * (64 * tl + lane) + 63); d = d > 128 ? 128 : d;
        sc[tl] = valu_tile(KT, VT, QSh, PWh, lane, true, BTl[d * 16 + hh], mc, lc, oc);
        __syncthreads();
    }
    { const float inv = 1.f / lc;
#pragma unroll
      for (int tl = 0; tl < 4; ++tl) IMP[h * 264 + 64 * tl + lane] = fexp2(sc[tl] - mc) * inv;
      oc *= inv; }
    __syncthreads();
    if (tid < 256) { float s = 0.f;
#pragma unroll
        for (int hq = 0; hq < 8; ++hq) s += IMP[hq * 264 + tid]; SCORE[tid] = s; }
    if (tid == 256) SCORE[256] = 2.0f;
    __syncthreads();
    if (h == 0) {
        unsigned keyv[5];
#pragma unroll
        for (int e = 0; e < 4; ++e) { const float s = SCORE[64 * e + lane]; keyv[e] = s >= 0.f ? __float_as_uint(s) + 1u : 0u; }
        keyv[4] = (lane == 0) ? __float_as_uint(SCORE[256]) + 1u : 0u;
        unsigned long long sel[5]; topk16<5>(keyv, sel, lane);
        int base = 0;
#pragma unroll
        for (int e = 0; e < 5; ++e) { const bool on = (sel[e] >> lane) & 1ull; const int pos = base + __popcll(sel[e] & ((1ull << lane) - 1ull)); if (on && pos < 16) SEL[pos] = 64 * e + lane; base += __popcll(sel[e]); }
        if (lane == 0) SEL[16] = base < 16 ? base : 16;
    }
    __syncthreads();
    const int nsel = SEL[16];
    float ms = NEG_INF, ls = 0.f, os = 0.f;
    auto sel_src = [&](int n) { const int idx = SEL[n]; VSrc s;
        if (idx < 256) { const int page = a.page_table[sb * 128 + (idx >> 1)]; const size_t off = (((size_t)page * 128 + (idx & 1) * 64 + key) * 2 + g) * 64 + c8 * 8; s.k = a.cache_k_slc + off; s.v = a.cache_v_slc + off; s.ok = true; }
        else { const size_t off = ((size_t)(sb * 4 + (key & 3)) * 2 + g) * 64 + c8 * 8; s.k = a.out + O_SKC + 2 * SZ_SKV + off; s.v = a.out + O_SKC + 3 * SZ_SKV + off; s.ok = key < 4; }
        return s; };
    if (nsel > 0) { src = sel_src(0); vfetch(vr, src); }
    for (int n = 0; n < nsel; ++n) {
        vstore(vr, L, tid); __syncthreads();
        const int idx = SEL[n];
        if (n + 1 < nsel) { src = sel_src(n + 1); vfetch(vr, src); }
        int d = qpos - (64 * idx + lane); const bool ok = d >= 0; d = d < 0 ? 0 : (d > 128 ? 128 : d);
        (void)valu_tile(KT, VT, QSh, PWh, lane, ok, BTl[d * 16 + hh], ms, ls, os);
        __syncthreads();
    }
    float mw = NEG_INF, lw = 0.f, ow = 0.f;
    auto win_src = [&](int n) { VSrc s;
        if (n < 8) { const size_t off = (((size_t)sb * 512 + 64 * n + key) * 2 + g) * 64 + c8 * 8; s.k = a.cache_k_win + off; s.v = a.cache_v_win + off; s.ok = true; }
        else { const size_t off = (((size_t)sb * 512 + 508 + (key & 3)) * 2 + g) * 64 + c8 * 8; s.k = a.out + O_SKW + off; s.v = a.out + O_SKW + SZ_SW + off; s.ok = key < 4; }
        return s; };
    src = win_src(0); vfetch(vr, src);
    for (int n = 0; n < 9; ++n) {
        vstore(vr, L, tid); __syncthreads();
        if (n + 1 < 9) { src = win_src(n + 1); vfetch(vr, src); }
        int d; bool ok;
        if (n < 8) { const int r = 64 * n + lane; d = 512 + t - r; ok = r >= t; } else { d = t - lane; ok = lane <= t; }
        d = d < 0 ? 0 : (d > 128 ? 128 : d);
        (void)valu_tile(KT, VT, QSh, PWh, lane, ok, BTl[d * 16 + hh], mw, lw, ow);
        __syncthreads();
    }
    const float* Gt = (const float*)(a.ws + WS_G) + row * 48;
    const float o = Gt[hh] * oc + Gt[16 + hh] * (ls > 0.f ? os / ls : 0.f) + Gt[32 + hh] * (lw > 0.f ? ow / lw : 0.f);
    const int col = g * 512 + h * 64 + lane;
    const float sz = bf2f(((const bf16_t*)(a.ws + WS_SZA))[row * DM + col]);
    ((bf16_t*)(a.ws + WS_A2))[row * DMIX + col] = (bf16_t)(pk_bf16(o * sz, 0.f) & 0xffffu);
    __syncthreads();
}

constexpr int NPHASE = 7;
__global__ void __launch_bounds__(512, 2) fwd(Args a) {
    extern __shared__ __attribute__((aligned(16))) unsigned char lds_raw[];
    Frame F; F.lds = (LAS unsigned char*)lds_raw; F.tid = threadIdx.x; F.lane = F.tid & 63; F.wave = __builtin_amdgcn_readfirstlane(F.tid >> 6); F.G = gridDim.x; F.bid = blockIdx.x;
    for (int u = F.tid; u < (LDS_BYTES - LDS_CTL) / 4; u += 512) ((LAS unsigned*)(F.lds + LDS_CTL))[u] = 0u;
    __syncthreads();
    unsigned* ctl = (unsigned*)(a.ws + WS_CTL);
    XcdBarrier bar = xcd_barrier_post(ctl + 4096, (volatile LAS unsigned*)(F.lds + LDS_CTL));
    const int lo = a.ph_lo, hi = a.ph_hi;
#define IN(k) (lo <= (k) && (k) < hi)
#define SEAM(k) do { if (IN(k) && IN((k) + 1)) xcd_barrier(bar); } while (0)
    const int vcu = (F.G % 8 == 0) ? (F.bid % 8) * (F.G / 8) + F.bid / 8 : F.bid;
    if (IN(0)) { p0a(a, F); }
    SEAM(0);
    if (IN(1)) {
        p0b_rows(a, F);
        for (int u = F.bid; u < 256; u += F.G) compress_unit<0>(a, F, u >> 7, u & 127);
    }
    SEAM(1);
    if (IN(2)) {
        pg8::Gemm g{(const bf16_t*)(a.ws + WS_H), (const bf16_t*)(a.ws + WS_WINT), MROWS, NIN_PAD, DM};
        pg8::StaticOrder S; S.init(MROWS, NIN_PAD, F.G, F.bid);
        EpiIn E{a.out, a.ws};
        pg8::gemm_phase<EpiIn, pg8::StaticOrder, true, true>(F.lds, g, S, E);
    }
    SEAM(2);
    if (IN(3)) {
        for (int u = F.bid; u < 16; u += F.G) compress_unit<1>(a, F, u >> 3, u & 7);
        for (int u = vcu; u < 256; u += F.G) sample_unit(a, F, u >> 3, (u >> 2) & 1, u & 3);
        for (int u = vcu; u < 1024; u += F.G) { const int v = u & 255, k = u >> 8, s = v & 31; const int qb = k == 0 ? s : (k == 1 ? 63 - s : (k == 2 ? 64 + s : 127 - s));
            win_unit(a, F, v >> 6, (v >> 5) & 1, qb); }
        conv_rows(a, F); a2_zero_pad(a, F);
    }
    SEAM(3);
    if (IN(4)) {
        for (int u = vcu; u < 1024; u += F.G) { const int v = u & 255, k = u >> 8, s = v & 31; const int qb = k == 0 ? s : (k == 1 ? 63 - s : (k == 2 ? 64 + s : 127 - s));
            nsa_unit(a, F, v >> 6, (v >> 5) & 1, qb); }
    }
    SEAM(4);
    if (IN(5)) {
        pg8::Gemm g{(const bf16_t*)(a.ws + WS_A2), (const bf16_t*)(a.ws + WS_WOUTT), MROWS, DM, DMIX};
        pg8::StaticOrder S; S.init(MROWS, DM, F.G, F.bid);
        EpiOut E{a.out, a.ws, a.x_prompt, a.x_sample};
        pg8::gemm_phase<EpiOut, pg8::StaticOrder, true, true>(F.lds, g, S, E);
    }
    SEAM(5);
    if (IN(6)) { p5_rows(a, F); }
#undef IN
#undef SEAM
}

#ifndef MK_PER_PHASE
#define MK_PER_PHASE 0
#endif
extern "C" void kernel_launch(void* const* d_in, const int* in_sizes, int n_in, void* d_out, int out_size, void* d_ws, size_t ws_size, hipStream_t stream) {
    static int grid = 0;
    if (grid == 0) {
        if (n_in != 26 || (size_t)out_size != O_END || ws_size < WS_END) { fprintf(stderr, "kernel_launch: unexpected shapes: n_in %d out %d ws %zu\n", n_in, out_size, ws_size); grid = -1; return; }
        int dev = 0, cus = 0, per_cu = 0;
        if (hipGetDevice(&dev) != hipSuccess || hipDeviceGetAttribute(&cus, hipDeviceAttributeMultiprocessorCount, dev) != hipSuccess) { grid = -1; return; }
        if (hipFuncSetAttribute((const void*)fwd, hipFuncAttributeMaxDynamicSharedMemorySize, LDS_BYTES) != hipSuccess) { fprintf(stderr, "kernel_launch: hipFuncSetAttribute failed\n"); grid = -1; return; }
        if (hipOccupancyMaxActiveBlocksPerMultiprocessor(&per_cu, (const void*)fwd, 512, LDS_BYTES) != hipSuccess || per_cu < 1) { fprintf(stderr, "kernel_launch: occupancy query says %d\n", per_cu); }
        (void)hipGetLastError();
        grid = cus;
    }
    if (grid < 0) return;
    (void)hipMemsetAsync((char*)d_ws + WS_CTL, 0, CTL_ZERO_BYTES, stream);
    Args a{};
    a.x_prompt = (const float*)d_in[0]; a.x_sample = (const float*)d_in[1];
    a.cache_k_cmp = (const float*)d_in[2]; a.cache_v_cmp = (const float*)d_in[3]; a.cache_k_slc = (const float*)d_in[4]; a.cache_v_slc = (const float*)d_in[5];
    a.cache_k_win = (const float*)d_in[6]; a.cache_v_win = (const float*)d_in[7]; a.state_conv = (const float*)d_in[8]; a.page_table = (const int*)d_in[9];
    a.c_prompt = (const float*)d_in[10]; a.c_sample = (const float*)d_in[11]; a.ada_w = (const float*)d_in[12]; a.ada_b = (const float*)d_in[13]; a.norm_g = (const float*)d_in[14]; a.w_in = (const float*)d_in[15];
    a.cmp_pe_k = (const float*)d_in[16]; a.cmp_w1_k = (const float*)d_in[17]; a.cmp_w2_k = (const float*)d_in[18]; a.cmp_pe_v = (const float*)d_in[19]; a.cmp_w1_v = (const float*)d_in[20]; a.cmp_w2_v = (const float*)d_in[21];
    a.conv_w = (const float*)d_in[22]; a.w_out = (const float*)d_in[23]; a.rel_bias = (const float*)d_in[24]; a.final_g = (const float*)d_in[25];
    a.out = (float*)d_out; a.ws = (unsigned char*)d_ws;
#if MK_PER_PHASE
    for (int p = 0; p < NPHASE; ++p) { a.ph_lo = p; a.ph_hi = p + 1; hipLaunchKernelGGL(fwd, dim3(grid), dim3(512), LDS_BYTES, stream, a); }
#else
    a.ph_lo = 0; a.ph_hi = NPHASE;
    hipLaunchKernelGGL(fwd, dim3(grid), dim3(512), LDS_BYTES, stream, a);
#endif
    const hipError_t le = hipPeekAtLastError();
    if (le != hipSuccess) fprintf(stderr, "kernel_launch: launch failed: %s\n", hipGetErrorName(le));
}
```

```cpp
#include <hip/hip_runtime.h>
#include <cstdio>
#include <cstdint>

#define LAS __attribute__((address_space(3)))
#define GAS __attribute__((address_space(1)))
typedef unsigned short bf16_t;
typedef short bf16x8 __attribute__((ext_vector_type(8)));
typedef float f32x4 __attribute__((ext_vector_type(4)));
typedef unsigned u32x4 __attribute__((ext_vector_type(4)));
typedef unsigned u32x2 __attribute__((ext_vector_type(2)));

constexpr int DM = 1024, SEQ = 8192, NB = 4, DB = 32, DS = 4, PAST = 16384;
constexpr int NPR = NB * SEQ;
constexpr int NSR = DB * DS;
constexpr int MROWS = 33024;
constexpr int DIN = 6960, NIN_PAD = 7168, DMIX = 2048;
constexpr int C_Q = 0, C_KV = 1024, C_G = 1792, C_HC = 1840, C_BC = 2864, C_CC = 3888, C_ZA = 4912, C_ZC = 5936;
constexpr float LOG2E = 1.4426950408889634f;
constexpr float QSCALE = 0.125f * LOG2E;
constexpr float EPS = 1e-6f;
constexpr float NEG_INF = -__builtin_inff();

constexpr size_t O_YP = 0;
constexpr size_t O_YS = O_YP + (size_t)NPR * DM;
constexpr size_t O_PKC = O_YS + (size_t)NSR * DM;
constexpr size_t SZ_PKV = (size_t)NPR * 128;
constexpr size_t O_PKW = O_PKC + 4 * SZ_PKV;
constexpr size_t SZ_PW = (size_t)NB * 512 * 128;
constexpr size_t O_PCV = O_PKW + 2 * SZ_PW;
constexpr size_t O_SKC = O_PCV + (size_t)NB * 2 * 1024;
constexpr size_t SZ_SKV = (size_t)NSR * 128;
constexpr size_t O_SKW = O_SKC + 4 * SZ_SKV;
constexpr size_t SZ_SW = (size_t)DB * 512 * 128;
constexpr size_t O_SCV = O_SKW + 2 * SZ_SW;
constexpr size_t O_END = O_SCV + (size_t)DB * 2 * 1024;
static_assert(O_END == 55320576, "output size");

constexpr size_t MiB = 1u << 20;
constexpr size_t WS_CTL = 0, CTL_ZERO_BYTES = 1 * MiB;
constexpr size_t WS_MOD = 1 * MiB;
constexpr size_t WS_BT = 1 * MiB + 512 * 1024;
constexpr size_t WS_B1 = WS_BT + 16384;
constexpr size_t WS_WINT = 2 * MiB;
constexpr size_t WS_WOUTT = 18 * MiB;
constexpr size_t WS_W1T = 22 * MiB;
constexpr size_t WS_KCMPP = 24 * MiB;
constexpr size_t WS_VCMPT = 24 * MiB + 512 * 1024;
constexpr size_t WS_KCMPS = 25 * MiB;
constexpr size_t WS_VCMPS = 29 * MiB;
constexpr size_t WS_G = 33 * MiB;
constexpr size_t WS_RSQ = 40 * MiB;
constexpr size_t WS_H = 48 * MiB;
constexpr size_t WS_Q = 114 * MiB;
constexpr size_t WS_SZA = 179 * MiB;
constexpr size_t WS_U = 244 * MiB;
constexpr size_t WS_BCZ = 309 * MiB;
constexpr size_t WS_OWIN = 374 * MiB;
constexpr size_t WS_A2 = 439 * MiB;
constexpr size_t WS_KC = 568 * MiB;
constexpr size_t WS_VC = 576 * MiB, WS_KSL = 584 * MiB, WS_KW = 592 * MiB, WS_VSLT = 600 * MiB, WS_VWT = 608 * MiB;
constexpr size_t WS_END = 616 * MiB;

constexpr int LDS_CTL = 153600;
constexpr int LDS_BYTES = 153600 + 1024;

__device__ __forceinline__ unsigned pk_bf16(float lo, float hi) { unsigned r; asm("v_cvt_pk_bf16_f32 %0, %1, %2" : "=v"(r) : "v"(lo), "v"(hi)); return r; }
__device__ __forceinline__ float bf2f(unsigned short b) { return __uint_as_float(((unsigned)b) << 16); }
__device__ __forceinline__ float bflo(unsigned w) { return __uint_as_float(w << 16); }
__device__ __forceinline__ float bfhi(unsigned w) { return __uint_as_float(w & 0xffff0000u); }
__device__ __forceinline__ float fexp2(float x) { return __builtin_amdgcn_exp2f(x); }
__device__ __forceinline__ float frcp(float x) { return __builtin_amdgcn_rcpf(x); }
__device__ __forceinline__ float sigmoidf_(float x) { return frcp(1.f + fexp2(-LOG2E * x)); }
__device__ __forceinline__ float siluf_(float x) { return x * sigmoidf_(x); }
__device__ __forceinline__ float wave_sum(float v) {
#pragma unroll
    for (int o = 1; o < 64; o <<= 1) v += __shfl_xor(v, o);
    return v;
}
__device__ __forceinline__ float wave_max(float v) {
#pragma unroll
    for (int o = 1; o < 64; o <<= 1) v = fmaxf(v, __shfl_xor(v, o));
    return v;
}
#define LDS_WAIT() asm volatile("s_waitcnt lgkmcnt(0)" ::: "memory")
#define VM_WAIT() asm volatile("s_waitcnt vmcnt(0)" ::: "memory")

#define XB_TMO      128
#define XB_XCNT(j)  (256  + 64 * (j))
#define XB_XSUB(j)  (1280 + 64 * (j))
#define XB_XGEN(j)  (2304 + 64 * (j))
#define XB_TOP      3328
#define XB_TOPGEN   3392
#define XCD_BAR_WORDS 3456
#define XB_SPIN_CAP (1u << 18)
__device__ __forceinline__ unsigned xb_ld(unsigned* p)              { return __hip_atomic_load(p, __ATOMIC_RELAXED, __HIP_MEMORY_SCOPE_AGENT); }
__device__ __forceinline__ unsigned xb_add(unsigned* p, unsigned v) { return __hip_atomic_fetch_add(p, v, __ATOMIC_RELAXED, __HIP_MEMORY_SCOPE_AGENT); }
__device__ __forceinline__ unsigned xb_xcc_id() { return (unsigned)__builtin_amdgcn_s_getreg((3 << 11) | 20) & 0xFu; }
#define XB_SPIN(cond, bar) do { unsigned _sp = 0; while (cond) { __builtin_amdgcn_s_sleep(1); \
    if ((++_sp & 255u) == 0u) { if (xb_ld(&(bar)[XB_TMO])) break; if (_sp > XB_SPIN_CAP) { atomicAdd(&(bar)[XB_TMO], 1u); break; } } } } while (0)
struct XcdBarrier { unsigned* bar; unsigned x; volatile LAS unsigned* st; };
__device__ __forceinline__ XcdBarrier xcd_barrier_post(unsigned* bar, volatile LAS unsigned* st) {
    XcdBarrier b; b.bar = bar; b.x = xb_xcc_id(); b.st = st;
    if (threadIdx.x == 0) (void)xb_add(&bar[XB_XCNT(b.x)], 1u);
    return b;
}
__device__ __forceinline__ void xcd_barrier_complete(unsigned* bar, unsigned x, unsigned& nloc, unsigned& nx) {
    const unsigned G = gridDim.x * gridDim.y * gridDim.z;
    unsigned sum, cnt, mine, sp = 0u;
    for (;;) {
        sum = 0u; cnt = 0u; mine = 0u;
#pragma unroll
        for (unsigned j = 0; j < 16; ++j) { const unsigned c = xb_ld(&bar[XB_XCNT(j)]); sum += c; cnt += (c > 0u) ? 1u : 0u; mine = (j == x) ? c : mine; }
        if (sum == G) break;
        __builtin_amdgcn_s_sleep(1);
        if ((++sp & 255u) == 0u) { if (xb_ld(&bar[XB_TMO])) break; if (sp > XB_SPIN_CAP) { atomicAdd(&bar[XB_TMO], 1u); break; } }
    }
    nloc = mine > 0u ? mine : 1u; nx = cnt > 0u ? cnt : 1u;
}
__device__ __forceinline__ void xcd_barrier(const XcdBarrier& b) {
    asm volatile("s_waitcnt vmcnt(0)" ::: "memory");
    __syncthreads();
    if (threadIdx.x == 0) {
        unsigned* bar = b.bar;
        __builtin_amdgcn_s_waitcnt(0);
        unsigned nloc = b.st[0], nx = b.st[1];
        if (nloc == 0u) { xcd_barrier_complete(bar, b.x, nloc, nx); b.st[0] = nloc; b.st[1] = nx; }
        const unsigned old = xb_add(&bar[XB_XSUB(b.x)], 1u);
        const unsigned gen = old / nloc;
        if (old + 1u == (gen + 1u) * nloc) {
            __builtin_amdgcn_fence(__ATOMIC_RELEASE, "agent");
            asm volatile("s_waitcnt vmcnt(0)" ::: "memory");
            const unsigned og = xb_add(&bar[XB_TOP], 1u);
            const unsigned tg = og / nx;
            if (og + 1u == (tg + 1u) * nx) xb_add(&bar[XB_TOPGEN], 1u);
            else XB_SPIN(xb_ld(&bar[XB_TOPGEN]) == tg, bar);
            __builtin_amdgcn_fence(__ATOMIC_ACQUIRE, "agent");
            xb_add(&bar[XB_XGEN(b.x)], 1u);
            asm volatile("s_waitcnt vmcnt(0)" ::: "memory");
        } else {
            XB_SPIN(xb_ld(&bar[XB_XGEN(b.x)]) == gen, bar);
            __builtin_amdgcn_fence(__ATOMIC_ACQUIRE, "agent");
            asm volatile("s_waitcnt vmcnt(0)" ::: "memory");
        }
    }
    __syncthreads();
}

namespace pg8 {
constexpr int BM = 256, BK = 64, HALF = 128, HTB = HALF * BK * 2, STAGE_BYTES = 8 * HTB, NXCD = 8, WGM = 8;
__host__ __device__ __forceinline__ int lds_byte(int r, int c) { const int st = (r >> 4) * 2 + (c >> 5), rr = r & 15, cc = c & 31, ob = rr * 64 + cc * 2; return st * 1024 + (ob ^ (((ob >> 9) & 1) << 5)); }
__host__ __device__ __forceinline__ void stage_rc(int b, int& R, int& C) { const int st = b / 1024, sb = b % 1024, swz = sb ^ (((sb >> 9) & 1) << 5); R = (st >> 1) * 16 + swz / 64; C = (st & 1) * 32 + (swz % 64) / 2; }
struct Unit { int pm, pn; };
struct Gemm { const bf16_t* A; const bf16_t* Bt; int M, N, K; };
struct StaticOrder {
    int nM, nN, nwg, G, c;
    __host__ __device__ void init(int M, int N, int G_, int c_) { nM = M / BM; nN = N / BM; nwg = nM * nN; G = G_; c = c_; }
    __host__ __device__ bool next(int i, Unit& u) const {
        const long L = (long)i * G + c; if (L >= nwg) return false;
        int wgid = (int)L; { const int q = nwg / NXCD, r = nwg % NXCD, xcd = wgid % NXCD, off = wgid / NXCD; wgid = (xcd < r ? xcd * (q + 1) : r * (q + 1) + (xcd - r) * q) + off; }
        const int nig = WGM * nN, gid = wgid / nig, fm = gid * WGM, gsz = (nM - fm) < WGM ? (nM - fm) : WGM;
        u.pm = fm + ((wgid % nig) % gsz); u.pn = (wgid % nig) / gsz; return true;
    }
    __device__ __forceinline__ void a_ready(const Unit&) const {}
    __device__ __forceinline__ void done(const Unit&) const {}
};
template <class Epi, class Sched, bool ALIGN_EPI = false, bool SP2 = false>
__device__ __forceinline__ void gemm_phase(LAS unsigned char* lds, const Gemm g, const Sched& S, const Epi& E) {
    const int tid = threadIdx.x, wid = __builtin_amdgcn_readfirstlane(tid >> 6), lane = tid & 63, wr = wid >> 2, wc = wid & 3, fr = lane & 15, fq = lane >> 4;
    const int K = g.K, nt = K / BK;
    unsigned voffA[2], voffB[2];
#pragma unroll
    for (int i = 0; i < 2; ++i) { int R, C; stage_rc(tid * 16 + i * 8192, R, C); voffA[i] = (unsigned)(R * K + C) * 2u; voffB[i] = (unsigned)(R * K + C) * 2u; }
    const size_t kstep = (size_t)(BK * 2);
    const size_t hstep = (size_t)HALF * K * 2;
    const size_t tstep = 2 * hstep;
    const unsigned ldsw = (unsigned)wid * 1024u;
    const int aoff = lds_byte(wr * 64 + fr, fq * 8), boff = lds_byte(wc * 32 + fr, fq * 8);
#define PG8_SA(b, h) (((b) * 2 + (h)) * HTB)
#define PG8_SB(b, h) ((4 + (b) * 2 + (h)) * HTB)
#define PG8_STAGE(bufoff, gbase, voff) do { _Pragma("unroll") for (int _i = 0; _i < 2; ++_i) \
        __builtin_amdgcn_global_load_lds((const unsigned*)((const char*)(gbase) + (voff)[_i]), (LAS unsigned*)(lds + (bufoff) + ldsw + _i * 8192), 16, 0, 0); } while (0)
#define PG8_LDA(dst, b, h) do { _Pragma("unroll") for (int m = 0; m < 4; ++m) _Pragma("unroll") for (int k = 0; k < 2; ++k) dst[m][k] = *(const LAS bf16x8*)(lds + PG8_SA(b, h) + aoff + m * 2048 + k * 1024); } while (0)
#define PG8_LDB(dst, b, h) do { _Pragma("unroll") for (int n = 0; n < 2; ++n) _Pragma("unroll") for (int k = 0; k < 2; ++k) dst[n][k] = *(const LAS bf16x8*)(lds + PG8_SB(b, h) + boff + n * 2048 + k * 1024); } while (0)
#define PG8_MMA(ai, bj, At, Bt) do { __builtin_amdgcn_s_setprio(1); _Pragma("unroll") for (int m = 0; m < 4; ++m) _Pragma("unroll") for (int n = 0; n < 2; ++n) _Pragma("unroll") for (int k = 0; k < 2; ++k) \
        acc[ai][bj][m][n] = __builtin_amdgcn_mfma_f32_16x16x32_bf16(Bt[n][k], At[m][k], acc[ai][bj][m][n], 0, 0, 0); __builtin_amdgcn_s_setprio(0); } while (0)
#define PG8_WAIT_V(n) asm volatile("s_waitcnt vmcnt(" #n ")" ::: "memory")
#define PG8_WAIT_L(n) asm volatile("s_waitcnt lgkmcnt(" #n ")" ::: "memory")
#define PG8_BAR __builtin_amdgcn_s_barrier()
#define PG8_SCHED __builtin_amdgcn_sched_barrier(0)
    Unit cur, nxt; int ui = 0;
    if (!S.next(0, cur)) return;
    f32x4 acc[2][2][4][2];
#pragma unroll
    for (int a = 0; a < 2; ++a)
#pragma unroll
        for (int b = 0; b < 2; ++b)
#pragma unroll
            for (int m = 0; m < 4; ++m)
#pragma unroll
                for (int n = 0; n < 2; ++n) acc[a][b][m][n] = (f32x4){0.f, 0.f, 0.f, 0.f};
    bf16x8 At[4][2], B0[2][2], B1[2][2];
    const char* cA = (const char*)g.A + (size_t)cur.pm * tstep; const char* cB = (const char*)g.Bt + (size_t)cur.pn * tstep;
    S.a_ready(cur);
    if constexpr (SP2) {
        PG8_STAGE(PG8_SB(0, 0), cB, voffB); PG8_STAGE(PG8_SB(0, 1), cB + hstep, voffB); PG8_STAGE(PG8_SA(0, 0), cA, voffA); PG8_STAGE(PG8_SA(0, 1), cA + hstep, voffA);
        if (wr == 1) PG8_BAR;
        PG8_WAIT_V(2); PG8_BAR;
        PG8_STAGE(PG8_SB(1, 0), cB + kstep, voffB); PG8_STAGE(PG8_SA(1, 0), cA + kstep, voffA); PG8_STAGE(PG8_SB(1, 1), cB + hstep + kstep, voffB);
        PG8_WAIT_V(6); PG8_BAR;
    } else {
        PG8_STAGE(PG8_SB(0, 0), cB, voffB); PG8_STAGE(PG8_SA(0, 0), cA, voffA); PG8_STAGE(PG8_SB(0, 1), cB + hstep, voffB); PG8_STAGE(PG8_SA(0, 1), cA + hstep, voffA);
        if (wr == 1) PG8_BAR;
        PG8_WAIT_V(4); PG8_BAR;
        PG8_STAGE(PG8_SB(1, 0), cB + kstep, voffB); PG8_STAGE(PG8_SA(1, 0), cA + kstep, voffA); PG8_STAGE(PG8_SB(1, 1), cB + hstep + kstep, voffB);
        PG8_WAIT_V(6); PG8_BAR;
    }
    for (;;) {
        const bool has_next = S.next(ui + 1, nxt);
        const char* nA = has_next ? (const char*)g.A + (size_t)nxt.pm * tstep : cA; const char* nB = has_next ? (const char*)g.Bt + (size_t)nxt.pn * tstep : cB;
        for (int t = 0; t < nt; t += 2) {
            const bool last = (t == nt - 2);
            const char* a1 = cA + (size_t)(t + 1) * kstep;
            const char* a2 = last ? nA : cA + (size_t)(t + 2) * kstep; const char* b2 = last ? nB : cB + (size_t)(t + 2) * kstep;
            const char* a3 = a2 + kstep; const char* b3 = b2 + kstep;
            if (last && has_next) S.a_ready(nxt);
            if constexpr (SP2) {
            PG8_LDB(B0, 0, 0); PG8_LDB(B1, 0, 1); PG8_SCHED; PG8_LDA(At, 0, 0); PG8_STAGE(PG8_SA(1, 1), a1 + hstep, voffA);
            PG8_WAIT_V(8); PG8_WAIT_L(0); PG8_BAR; PG8_MMA(0, 0, At, B0); PG8_MMA(0, 1, At, B1); PG8_BAR; PG8_SCHED;
            PG8_LDA(At, 0, 1); PG8_STAGE(PG8_SB(0, 0), b2, voffB); PG8_STAGE(PG8_SB(0, 1), b2 + hstep, voffB); PG8_STAGE(PG8_SA(0, 0), a2, voffA);
            PG8_WAIT_V(8); PG8_WAIT_L(0); PG8_BAR; PG8_MMA(1, 0, At, B0); PG8_MMA(1, 1, At, B1); PG8_BAR; PG8_SCHED;
            PG8_LDB(B0, 1, 0); PG8_LDB(B1, 1, 1); PG8_SCHED; PG8_LDA(At, 1, 0); PG8_STAGE(PG8_SA(0, 1), a2 + hstep, voffA);
            PG8_WAIT_V(8); PG8_WAIT_L(0); PG8_BAR; PG8_MMA(0, 0, At, B0); PG8_MMA(0, 1, At, B1); PG8_BAR; PG8_SCHED;
            PG8_LDA(At, 1, 1); PG8_STAGE(PG8_SB(1, 0), b3, voffB); PG8_STAGE(PG8_SB(1, 1), b3 + hstep, voffB); PG8_STAGE(PG8_SA(1, 0), a3, voffA);
            PG8_WAIT_V(8); PG8_WAIT_L(0); PG8_BAR; PG8_MMA(1, 0, At, B0); PG8_MMA(1, 1, At, B1); PG8_BAR; PG8_SCHED;
            } else {
            PG8_LDB(B0, 0, 0); PG8_SCHED; PG8_LDA(At, 0, 0); PG8_STAGE(PG8_SA(1, 1), a1 + hstep, voffA);
            PG8_WAIT_L(8); PG8_BAR; PG8_WAIT_L(0); PG8_MMA(0, 0, At, B0); PG8_BAR; PG8_SCHED;
            PG8_LDB(B1, 0, 1); PG8_STAGE(PG8_SB(0, 0), b2, voffB);
            PG8_BAR; PG8_WAIT_L(0); PG8_MMA(0, 1, At, B1); PG8_BAR;
            PG8_LDA(At, 0, 1); PG8_STAGE(PG8_SA(0, 0), a2, voffA);
            PG8_BAR; PG8_WAIT_L(0); PG8_MMA(1, 0, At, B0); PG8_BAR; PG8_SCHED;
            PG8_STAGE(PG8_SB(0, 1), b2 + hstep, voffB);
            PG8_WAIT_V(6); PG8_BAR; PG8_MMA(1, 1, At, B1); PG8_BAR;
            PG8_LDB(B0, 1, 0); PG8_SCHED; PG8_LDA(At, 1, 0); PG8_STAGE(PG8_SA(0, 1), a2 + hstep, voffA);
            PG8_WAIT_L(8); PG8_BAR; PG8_WAIT_L(0); PG8_MMA(0, 0, At, B0); PG8_BAR; PG8_SCHED;
            PG8_LDB(B1, 1, 1); PG8_STAGE(PG8_SB(1, 0), b3, voffB);
            PG8_BAR; PG8_WAIT_L(0); PG8_MMA(0, 1, At, B1); PG8_BAR;
            PG8_LDA(At, 1, 1); PG8_STAGE(PG8_SA(1, 0), a3, voffA);
            PG8_BAR; PG8_WAIT_L(0); PG8_MMA(1, 0, At, B0); PG8_BAR; PG8_SCHED;
            PG8_STAGE(PG8_SB(1, 1), b3 + hstep, voffB);
            PG8_WAIT_V(6); PG8_BAR; PG8_MMA(1, 1, At, B1); PG8_BAR;
            }
        }
        if constexpr (ALIGN_EPI) { if (wr == 0) PG8_BAR; }
        E(acc, cur, wr, wc, fr, fq); S.done(cur);
        if (!has_next) break;
#pragma unroll
        for (int a = 0; a < 2; ++a)
#pragma unroll
            for (int b = 0; b < 2; ++b)
#pragma unroll
                for (int m = 0; m < 4; ++m)
#pragma unroll
                    for (int n = 0; n < 2; ++n) acc[a][b][m][n] = (f32x4){0.f, 0.f, 0.f, 0.f};
        cur = nxt; cA = nA; cB = nB; ++ui;
        if constexpr (ALIGN_EPI) { if (wr == 1) PG8_BAR; }
    }
    PG8_WAIT_V(0);
    if constexpr (!ALIGN_EPI) { if (wr == 0) PG8_BAR; }
    PG8_BAR;
#undef PG8_SA
#undef PG8_SB
#undef PG8_STAGE
#undef PG8_LDA
#undef PG8_LDB
#undef PG8_MMA
#undef PG8_WAIT_V
#undef PG8_WAIT_L
#undef PG8_BAR
#undef PG8_SCHED
}
}

struct Args {
    const float* x_prompt; const float* x_sample;
    const float* cache_k_cmp; const float* cache_v_cmp; const float* cache_k_slc; const float* cache_v_slc;
    const float* cache_k_win; const float* cache_v_win; const float* state_conv; const int* page_table;
    const float* c_prompt; const float* c_sample; const float* ada_w; const float* ada_b; const float* norm_g; const float* w_in;
    const float* cmp_pe_k; const float* cmp_w1_k; const float* cmp_w2_k; const float* cmp_pe_v; const float* cmp_w1_v; const float* cmp_w2_v;
    const float* conv_w; const float* w_out; const float* rel_bias; const float* final_g;
    float* out; unsigned char* ws; int ph_lo, ph_hi;
};
struct Frame {
    LAS unsigned char* lds; int tid, lane, wave, G, bid;
};

__host__ __device__ __forceinline__ int vslot32(int kk) { return kk < 16 ? 8 * (kk >> 2) + (kk & 3) : 8 * ((kk - 16) >> 2) + 4 + (kk & 3); }
__host__ __device__ __forceinline__ int inv_perm32(int lo) { return 16 * ((lo >> 2) & 1) + 4 * (lo >> 3) + (lo & 3); }

__device__ __forceinline__ void transpose_item(const float* W, int ldw, int src0, int nvalid, bf16_t* WT, int K, int dst0, bool perm, int k0, LAS float* scr, int lane) {
    const int c = lane & 31;
#pragma unroll 8
    for (int i = 0; i < 32; ++i) { const int kk = 2 * i + (lane >> 5); scr[kk * 33 + c] = (c < nvalid) ? W[(size_t)(k0 + kk) * ldw + src0 + c] : 0.f; }
    LDS_WAIT(); asm volatile("" ::: "memory");
    const int c8 = lane & 7;
#pragma unroll
    for (int j = 0; j < 4; ++j) { const int n = (lane >> 3) + 8 * j; const LAS float* s = scr + (8 * c8) * 33 + n;
        u32x4 o; o.x = pk_bf16(s[0 * 33], s[1 * 33]); o.y = pk_bf16(s[2 * 33], s[3 * 33]); o.z = pk_bf16(s[4 * 33], s[5 * 33]); o.w = pk_bf16(s[6 * 33], s[7 * 33]);
        const int dn = perm ? inv_perm32(n) : n;
        *(u32x4*)(WT + (size_t)(dst0 + dn) * K + k0 + 8 * c8) = o; }
    LDS_WAIT(); asm volatile("" ::: "memory");
}
__device__ __forceinline__ void win_group_src(int pg, int& src0, int& nvalid) {
    const int pn = pg >> 3, bj = (pg >> 2) & 1, wc = pg & 3; nvalid = 32;
    if (pn < 4) src0 = C_Q + 256 * pn + 128 * bj + 32 * wc;
    else if (pn < 8) src0 = C_ZA + 256 * (pn - 4) + 128 * bj + 32 * wc;
    else if (pn < 11) src0 = C_KV + 128 * (2 * (pn - 8) + bj) + 32 * wc;
    else if (pn == 11) { src0 = C_G + 32 * wc; nvalid = bj ? 0 : (wc == 0 ? 32 : (wc == 1 ? 16 : 0)); if (nvalid == 0) src0 = 0; }
    else if (pn < 20) src0 = (bj ? C_CC : C_HC) + 128 * (pn - 12) + 32 * wc;
    else src0 = (bj ? C_ZC : C_BC) + 128 * (pn - 20) + 32 * wc;
}

__device__ __forceinline__ void p0a(const Args& a, Frame& F) {
    unsigned char* ws = a.ws;
    {
        LAS float* scr = (LAS float*)(F.lds + F.wave * 8704);
        const int gw = F.bid * 8 + F.wave, NGW = F.G * 8;
        constexpr int I_IN = 224 * 16, I_OUT = 32 * 32, I_W1 = 4 * 64;
        constexpr int NITEMS = I_IN + I_OUT + 2 * I_W1;
        for (int it = gw; it < NITEMS; it += NGW) {
            int r = it;
            if (r < I_IN) { const int pg = r >> 4, kb = r & 15; int src0, nv; win_group_src(pg, src0, nv);
                transpose_item(a.w_in, DIN, src0, nv, (bf16_t*)(ws + WS_WINT), DM, pg * 32, true, kb * 64, scr, F.lane); continue; }
            r -= I_IN;
            if (r < I_OUT) { const int pg = r >> 5, kb = r & 31;
                transpose_item(a.w_out, DM, pg * 32, 32, (bf16_t*)(ws + WS_WOUTT), DMIX, pg * 32, true, kb * 64, scr, F.lane); continue; }
            r -= I_OUT;
            const int kv = r >= I_W1; if (kv) r -= I_W1;
            { const int pg = r >> 6, kb = r & 63;
              transpose_item(kv ? a.cmp_w1_v : a.cmp_w1_k, 128, pg * 32, 32, (bf16_t*)(ws + WS_W1T) + (size_t)kv * 128 * 4096, 4096, pg * 32, false, kb * 64, scr, F.lane); }
        }
    }
    __syncthreads();
    {
        LAS float* CS = (LAS float*)(F.lds) + F.wave * (18 * 128);
        LAS float* RED = (LAS float*)(F.lds + 73728);
        float* MOD = (float*)(ws + WS_MOD);
        for (int job = F.bid; job < 96; job += F.G) {
            const int cg = job >> 1, rh = job & 1, n = cg * 64 + F.lane, kb = F.wave * 128;
            for (int i = F.lane; i < 18 * 128; i += 64) { const int r = rh * 18 + i / 128, k = kb + (i & 127);
                CS[i] = (r < 4) ? a.c_prompt[r * DM + k] : a.c_sample[(r - 4) * DM + k]; }
            LDS_WAIT(); asm volatile("" ::: "memory");
            float acc[18];
#pragma unroll
            for (int r = 0; r < 18; ++r) acc[r] = 0.f;
            for (int k16 = 0; k16 < 128; k16 += 16) {
                float wv[16];
#pragma unroll
                for (int i = 0; i < 16; ++i) wv[i] = a.ada_w[(size_t)(kb + k16 + i) * 3072 + n];
#pragma unroll
                for (int q = 0; q < 4; ++q)
#pragma unroll
                    for (int r = 0; r < 18; ++r) { const f32x4 c4 = *(const LAS f32x4*)(CS + r * 128 + k16 + 4 * q); acc[r] += c4.x * wv[4 * q] + c4.y * wv[4 * q + 1] + c4.z * wv[4 * q + 2] + c4.w * wv[4 * q + 3]; }
            }
#pragma unroll
            for (int r = 0; r < 18; ++r) RED[(F.wave * 18 + r) * 64 + F.lane] = acc[r];
            __syncthreads();
            for (int o = F.tid; o < 18 * 64; o += 512) { const int r = o >> 6, l = o & 63; float s = 0.f;
#pragma unroll
                for (int w = 0; w < 8; ++w) s += RED[(w * 18 + r) * 64 + l];
                MOD[(rh * 18 + r) * 3072 + cg * 64 + l] = s + a.ada_b[cg * 64 + l]; }
            __syncthreads();
        }
    }
    if (F.bid == F.G - 3) {
        float* BT = (float*)(ws + WS_BT);
        for (int i = F.tid; i < 129 * 16; i += 512) { const int d = i >> 4, hh = i & 15; int bk;
            if (d < 16) bk = d; else { int lg = 16 + (int)(log((double)d / 16.0) / log(8.0) * 16.0); bk = lg < 31 ? lg : 31; }
            BT[i] = a.rel_bias[bk * 16 + hh] * LOG2E; }
    }
    {
        const size_t per = (size_t)508 * 128 / 4;
        const size_t total = 2 * DB * per;
        for (size_t i = (size_t)F.bid * 512 + F.tid; i < total; i += (size_t)F.G * 512) {
            const int t = (int)(i / (DB * per)); const size_t r = i % (DB * per); const int sb = (int)(r / per); const size_t o = r % per;
            const f32x4* src = (const f32x4*)((t ? a.cache_v_win : a.cache_k_win) + ((size_t)sb * 512 + 4) * 128) + o;
            f32x4* dst = (f32x4*)(a.out + O_SKW + (size_t)t * SZ_SW + (size_t)sb * 512 * 128) + o;
            *dst = *src;
        }
    }
}

__device__ __forceinline__ void p0b_rows(const Args& a, Frame& F) {
    const float* MOD = (const float*)(a.ws + WS_MOD); bf16_t* H = (bf16_t*)(a.ws + WS_H);
    const int gw = F.bid * 8 + F.wave, NGW = F.G * 8;
    for (int row = gw; row < MROWS; row += NGW) {
        unsigned long long* o8 = (unsigned long long*)(H + (size_t)row * DM) + F.lane;
        if (row >= NPR + NSR) {
#pragma unroll
            for (int j = 0; j < 4; ++j) o8[64 * j] = 0ull;
            continue; }
        const float* xr; int mr;
        if (row < NPR) { xr = a.x_prompt + (size_t)row * DM; mr = row >> 13; } else { xr = a.x_sample + (size_t)(row - NPR) * DM; mr = 4 + ((row - NPR) >> 2); }
        const f32x4* x4 = (const f32x4*)xr + F.lane;
        f32x4 v[4]; float s = 0.f;
#pragma unroll
        for (int j = 0; j < 4; ++j) { v[j] = x4[64 * j]; s += (v[j].x * v[j].x + v[j].y * v[j].y) + (v[j].z * v[j].z + v[j].w * v[j].w); }
        const float rstd = 1.f / sqrtf(wave_sum(s) * (1.f / DM) + EPS);
        const float* shift = MOD + (size_t)mr * 3072; const float* scale = shift + 1024;
#pragma unroll
        for (int j = 0; j < 4; ++j) { const int c = 4 * F.lane + 256 * j;
            const f32x4 g = *(const f32x4*)(a.norm_g + c), sc = *(const f32x4*)(scale + c), sh = *(const f32x4*)(shift + c);
            const f32x4 y = (v[j] * rstd * g) * (sc + 1.f) + sh;
            o8[64 * j] = (unsigned long long)pk_bf16(y.x, y.y) | ((unsigned long long)pk_bf16(y.z, y.w) << 32); }
    }
}

struct EpiIn {
    float* out; unsigned char* ws;
    __device__ __forceinline__ void operator()(const f32x4 (&acc)[2][2][4][2], const pg8::Unit& u, int wr, int wc, int fr, int fq) const {
        const int pn = u.pn, lc0 = wc * 32 + fq * 8;
#pragma unroll
        for (int ai = 0; ai < 2; ++ai)
#pragma unroll
            for (int m = 0; m < 4; ++m) {
                const int row = u.pm * 256 + ai * 128 + wr * 64 + m * 16 + fr;
                if (row >= NPR + NSR) continue;
                const f32x4 a0 = acc[ai][0][m][0], a1 = acc[ai][0][m][1], b0 = acc[ai][1][m][0], b1 = acc[ai][1][m][1];
                if (pn < 4) {
                    bf16_t* d = (bf16_t*)(ws + WS_Q) + (size_t)row * DM + 256 * pn + lc0;
                    u32x4 w0, w1;
                    w0.x = pk_bf16(a0.x * QSCALE, a0.y * QSCALE); w0.y = pk_bf16(a0.z * QSCALE, a0.w * QSCALE); w0.z = pk_bf16(a1.x * QSCALE, a1.y * QSCALE); w0.w = pk_bf16(a1.z * QSCALE, a1.w * QSCALE);
                    w1.x = pk_bf16(b0.x * QSCALE, b0.y * QSCALE); w1.y = pk_bf16(b0.z * QSCALE, b0.w * QSCALE); w1.z = pk_bf16(b1.x * QSCALE, b1.y * QSCALE); w1.w = pk_bf16(b1.z * QSCALE, b1.w * QSCALE);
                    *(u32x4*)d = w0; *(u32x4*)(d + 128) = w1;
                } else if (pn < 8) {
                    bf16_t* d = (bf16_t*)(ws + WS_SZA) + (size_t)row * DM + 256 * (pn - 4) + lc0;
                    u32x4 w0, w1;
                    w0.x = pk_bf16(siluf_(a0.x), siluf_(a0.y)); w0.y = pk_bf16(siluf_(a0.z), siluf_(a0.w)); w0.z = pk_bf16(siluf_(a1.x), siluf_(a1.y)); w0.w = pk_bf16(siluf_(a1.z), siluf_(a1.w));
                    w1.x = pk_bf16(siluf_(b0.x), siluf_(b0.y)); w1.y = pk_bf16(siluf_(b0.z), siluf_(b0.w)); w1.z = pk_bf16(siluf_(b1.x), siluf_(b1.y)); w1.w = pk_bf16(siluf_(b1.z), siluf_(b1.w));
                    *(u32x4*)d = w0; *(u32x4*)(d + 128) = w1;
                } else if (pn < 11) {
#pragma unroll
                    for (int bj = 0; bj < 2; ++bj) {
                        const int ti = 2 * (pn - 8) + bj; const f32x4 v0 = bj ? b0 : a0, v1 = bj ? b1 : a1;
                        float* fo = nullptr;
                        if (row < NPR) {
                            const int s = row & (SEQ - 1), b = row >> 13;
                            if (ti < 4) fo = out + O_PKC + (size_t)ti * SZ_PKV + (size_t)row * 128 + lc0;
                            else if (s >= SEQ - 512) fo = out + O_PKW + (size_t)(ti - 4) * SZ_PW + ((size_t)b * 512 + (s - (SEQ - 512))) * 128 + lc0;
                            if (ti == 0 || ti == 1 || ti == 2 || ti == 4) {
                                const size_t base = ti == 0 ? WS_KC : ti == 1 ? WS_VC : ti == 2 ? WS_KSL : WS_KW;
                                u32x4 w; w.x = pk_bf16(v0.x, v0.y); w.y = pk_bf16(v0.z, v0.w); w.z = pk_bf16(v1.x, v1.y); w.w = pk_bf16(v1.z, v1.w);
                                *(u32x4*)((bf16_t*)(ws + base) + (size_t)row * 128 + lc0) = w;
                            } else {
                                bf16_t* vt = (bf16_t*)(ws + (ti == 3 ? WS_VSLT : WS_VWT));
                                const int g = lc0 >> 6, d0 = lc0 & 63, blk = s >> 6, kk = s & 63, slot = (kk & 32) + vslot32(kk & 31);
                                bf16_t* p = vt + (((size_t)(b * 2 + g) * 128 + blk) * 64 + d0) * 64 + slot;
                                const unsigned w0 = pk_bf16(v0.x, v0.y), w1 = pk_bf16(v0.z, v0.w), w2 = pk_bf16(v1.x, v1.y), w3 = pk_bf16(v1.z, v1.w);
                                p[0] = (bf16_t)w0; p[64] = (bf16_t)(w0 >> 16); p[128] = (bf16_t)w1; p[192] = (bf16_t)(w1 >> 16);
                                p[256] = (bf16_t)w2; p[320] = (bf16_t)(w2 >> 16); p[384] = (bf16_t)w3; p[448] = (bf16_t)(w3 >> 16);
                            }
                        } else {
                            const int sr = row - NPR, sb = sr >> 2, t = sr & 3;
                            if (ti < 4) fo = out + O_SKC + (size_t)ti * SZ_SKV + (size_t)sr * 128 + lc0;
                            else fo = out + O_SKW + (size_t)(ti - 4) * SZ_SW + ((size_t)sb * 512 + 508 + t) * 128 + lc0;
                        }
                        if (fo) { *(f32x4*)fo = v0; *(f32x4*)(fo + 4) = v1; }
                    }
                } else if (pn == 11) {
                    if (lc0 < 48) { float* d = (float*)(ws + WS_G) + (size_t)row * 48 + lc0;
                        *(f32x4*)d = (f32x4){sigmoidf_(a0.x), sigmoidf_(a0.y), sigmoidf_(a0.z), sigmoidf_(a0.w)};
                        *(f32x4*)(d + 4) = (f32x4){sigmoidf_(a1.x), sigmoidf_(a1.y), sigmoidf_(a1.z), sigmoidf_(a1.w)}; }
                } else if (pn < 20) {
                    const int ch = 128 * (pn - 12) + lc0; const f32x4 u0 = a0 * b0, u1 = a1 * b1;
                    u32x4 w; w.x = pk_bf16(u0.x, u0.y); w.y = pk_bf16(u0.z, u0.w); w.z = pk_bf16(u1.x, u1.y); w.w = pk_bf16(u1.z, u1.w);
                    *(u32x4*)((bf16_t*)(ws + WS_U) + (size_t)row * DM + ch) = w;
                    float* fo = nullptr;
                    if (row < NPR) { const int s = row & (SEQ - 1); if (s >= SEQ - 2) fo = out + O_PCV + ((size_t)(row >> 13) * 2 + (s - (SEQ - 2))) * 1024 + ch; }
                    else { const int sr = row - NPR, t = sr & 3; if (t >= 2) fo = out + O_SCV + ((size_t)(sr >> 2) * 2 + (t - 2)) * 1024 + ch; }
                    if (fo) { *(f32x4*)fo = u0; *(f32x4*)(fo + 4) = u1; }
                } else {
                    const int ch = 128 * (pn - 20) + lc0;
                    u32x4 w; w.x = pk_bf16(a0.x * siluf_(b0.x), a0.y * siluf_(b0.y)); w.y = pk_bf16(a0.z * siluf_(b0.z), a0.w * siluf_(b0.w));
                    w.z = pk_bf16(a1.x * siluf_(b1.x), a1.y * siluf_(b1.y)); w.w = pk_bf16(a1.z * siluf_(b1.z), a1.w * siluf_(b1.w));
                    *(u32x4*)((bf16_t*)(ws + WS_BCZ) + (size_t)row * DM + ch) = w;
                }
            }
    }
};

struct EpiOut {
    float* out; unsigned char* ws; const float* x_prompt; const float* x_sample;
    __device__ __forceinline__ void operator()(const f32x4 (&acc)[2][2][4][2], const pg8::Unit& u, int wr, int wc, int fr, int fq) const {
        const int pn = u.pn, lc0 = wc * 32 + fq * 8; const float* MOD = (const float*)(ws + WS_MOD); float* RSQ = (float*)(ws + WS_RSQ);
#pragma unroll
        for (int ai = 0; ai < 2; ++ai)
#pragma unroll
            for (int m = 0; m < 4; ++m) {
                const int row = u.pm * 256 + ai * 128 + wr * 64 + m * 16 + fr;
                const bool valid = row < NPR + NSR; float ss = 0.f;
                if (valid) {
                    const float* xr; float* yr; int mr;
                    if (row < NPR) { xr = x_prompt + (size_t)row * DM; yr = out + O_YP + (size_t)row * DM; mr = row >> 13; }
                    else { xr = x_sample + (size_t)(row - NPR) * DM; yr = out + O_YS + (size_t)(row - NPR) * DM; mr = 4 + ((row - NPR) >> 2); }
                    const float* gate = MOD + (size_t)mr * 3072 + 2048;
#pragma unroll
                    for (int bj = 0; bj < 2; ++bj)
#pragma unroll
                        for (int n = 0; n < 2; ++n) { const int c = 256 * pn + 128 * bj + lc0 + 4 * n;
                            const f32x4 o = *(const f32x4*)(xr + c) + *(const f32x4*)(gate + c) * acc[ai][bj][m][n];
                            ss += (o.x * o.x + o.y * o.y) + (o.z * o.z + o.w * o.w);
                            *(f32x4*)(yr + c) = o; }
                }
                ss += __shfl_xor(ss, 16); ss += __shfl_xor(ss, 32);
                if (valid && fq == 0) RSQ[(size_t)row * 16 + pn * 4 + wc] = ss;
            }
    }
};

__device__ __forceinline__ void p5_rows(const Args& a, Frame& F) {
    const float* RSQ = (const float*)(a.ws + WS_RSQ);
    const int gw = F.bid * 8 + F.wave, NGW = F.G * 8;
    for (int row = gw; row < NPR + NSR; row += NGW) {
        float s = (F.lane < 16) ? RSQ[(size_t)row * 16 + F.lane] : 0.f;
        s = wave_sum(s);
        const float rstd = 1.f / sqrtf(s * (1.f / DM) + EPS);
        f32x4* y4 = (f32x4*)(row < NPR ? a.out + O_YP + (size_t)row * DM : a.out + O_YS + (size_t)(row - NPR) * DM) + F.lane;
#pragma unroll
        for (int j = 0; j < 4; ++j) { const f32x4 g = *((const f32x4*)a.final_g + F.lane + 64 * j); y4[64 * j] = y4[64 * j] * rstd * g; }
    }
}

__device__ __forceinline__ void conv_rows(const Args& a, Frame& F) {
    const bf16_t* U = (const bf16_t*)(a.ws + WS_U); const bf16_t* BCZ = (const bf16_t*)(a.ws + WS_BCZ); bf16_t* A2 = (bf16_t*)(a.ws + WS_A2);
    const size_t total = (size_t)(NPR + NSR) * 128;
    for (size_t i = (size_t)F.bid * 512 + F.tid; i < total; i += (size_t)F.G * 512) {
        const int row = (int)(i >> 7), c = (int)(i & 127) * 8;
        float um2[8], um1[8], u0[8], bz[8];
        { const u32x4 w = *(const u32x4*)(U + (size_t)row * DM + c); u0[0] = bflo(w.x); u0[1] = bfhi(w.x); u0[2] = bflo(w.y); u0[3] = bfhi(w.y); u0[4] = bflo(w.z); u0[5] = bfhi(w.z); u0[6] = bflo(w.w); u0[7] = bfhi(w.w); }
        { const u32x4 w = *(const u32x4*)(BCZ + (size_t)row * DM + c); bz[0] = bflo(w.x); bz[1] = bfhi(w.x); bz[2] = bflo(w.y); bz[3] = bfhi(w.y); bz[4] = bflo(w.z); bz[5] = bfhi(w.z); bz[6] = bflo(w.w); bz[7] = bfhi(w.w); }
        int t; const float* st = nullptr;
        if (row < NPR) t = row & (SEQ - 1); else { t = (row - NPR) & 3; st = a.state_conv + (size_t)((row - NPR) >> 2) * 2 * 1024 + c; }
        if (t >= 1) { const u32x4 w = *(const u32x4*)(U + (size_t)(row - 1) * DM + c); um1[0] = bflo(w.x); um1[1] = bfhi(w.x); um1[2] = bflo(w.y); um1[3] = bfhi(w.y); um1[4] = bflo(w.z); um1[5] = bfhi(w.z); um1[6] = bflo(w.w); um1[7] = bfhi(w.w); }
        else if (st) {
#pragma unroll
            for (int j = 0; j < 8; ++j) um1[j] = st[1024 + j]; }
        else {
#pragma unroll
            for (int j = 0; j < 8; ++j) um1[j] = 0.f; }
        if (t >= 2) { const u32x4 w = *(const u32x4*)(U + (size_t)(row - 2) * DM + c); um2[0] = bflo(w.x); um2[1] = bfhi(w.x); um2[2] = bflo(w.y); um2[3] = bfhi(w.y); um2[4] = bflo(w.z); um2[5] = bfhi(w.z); um2[6] = bflo(w.w); um2[7] = bfhi(w.w); }
        else if (st) {
#pragma unroll
            for (int j = 0; j < 8; ++j) um2[j] = st[(t == 1 ? 1024 : 0) + j]; }
        else {
#pragma unroll
            for (int j = 0; j < 8; ++j) um2[j] = 0.f; }
        float r[8];
#pragma unroll
        for (int j = 0; j < 8; ++j) r[j] = (a.conv_w[c + j] * um2[j] + a.conv_w[1024 + c + j] * um1[j] + a.conv_w[2048 + c + j] * u0[j]) * bz[j];
        u32x4 o; o.x = pk_bf16(r[0], r[1]); o.y = pk_bf16(r[2], r[3]); o.z = pk_bf16(r[4], r[5]); o.w = pk_bf16(r[6], r[7]);
        *(u32x4*)(A2 + (size_t)row * DMIX + 1024 + c) = o;
    }
}
__device__ __forceinline__ void a2_zero_pad(const Args& a, Frame& F) {
    bf16_t* A2 = (bf16_t*)(a.ws + WS_A2) + (size_t)(NPR + NSR) * DMIX;
    const size_t total = (size_t)(MROWS - NPR - NSR) * DMIX / 8;
    for (size_t i = (size_t)F.bid * 512 + F.tid; i < total; i += (size_t)F.G * 512) *(u32x4*)(A2 + i * 8) = (u32x4){0u, 0u, 0u, 0u};
}

template <int MODE> __device__ __forceinline__ void compress_unit(const Args& a, Frame& F, int kv, int tl) {
    LAS unsigned char* L = F.lds;
    constexpr int PITCH = 72, STG = 128 * PITCH * 2;
    const int tid = F.tid, lane = F.lane, w = F.wave, r16 = lane & 15, kq = lane >> 4;
    const int R = tid >> 2, c4 = tid & 3;
    const float* srcf = nullptr; const bf16_t* srcb = nullptr;
    if (MODE == 0) { const int sb = tl >> 2, blk = (tl & 3) * 64 + (R >> 1), g = R & 1; const int page = a.page_table[sb * 128 + (blk >> 1)];
        srcf = (kv ? a.cache_v_cmp : a.cache_k_cmp) + (((size_t)page * 128 + (blk & 1) * 64) * 2 + g) * 64 + c4 * 16; }
    else { const int GR = tl * 128 + R, bblk = GR >> 1, g = GR & 1, b = bblk >> 7, blk = bblk & 127;
        srcb = (const bf16_t*)(a.ws + (kv ? WS_VC : WS_KC)) + ((size_t)(b * SEQ + blk * 64)) * 128 + g * 64 + c4 * 16; }
    const bf16_t* wsrc = (const bf16_t*)(a.ws + WS_W1T) + (size_t)kv * 128 * 4096 + (size_t)R * 4096 + c4 * 16;
    const int wm = w >> 1, wn = w & 1;
    f32x4 acc[2][4];
#pragma unroll
    for (int i = 0; i < 2; ++i)
#pragma unroll
        for (int j = 0; j < 4; ++j) acc[i][j] = (f32x4){0.f, 0.f, 0.f, 0.f};
    u32x4 ra[2], rb[2];
    const float* pe = (kv ? a.cmp_pe_v : a.cmp_pe_k) + c4 * 16;
    auto load = [&](int ks) {
        const f32x4* pp = (const f32x4*)(pe + ks * 64); const f32x4 e0 = pp[0], e1 = pp[1], e2 = pp[2], e3 = pp[3];
        f32x4 v0, v1, v2, v3;
        if (MODE == 0) { const f32x4* p = (const f32x4*)(srcf + (size_t)ks * 128); v0 = p[0]; v1 = p[1]; v2 = p[2]; v3 = p[3]; }
        else { const u32x4* p = (const u32x4*)(srcb + (size_t)ks * 128); const u32x4 w0 = p[0], w1 = p[1];
            v0 = (f32x4){bflo(w0.x), bfhi(w0.x), bflo(w0.y), bfhi(w0.y)}; v1 = (f32x4){bflo(w0.z), bfhi(w0.z), bflo(w0.w), bfhi(w0.w)};
            v2 = (f32x4){bflo(w1.x), bfhi(w1.x), bflo(w1.y), bfhi(w1.y)}; v3 = (f32x4){bflo(w1.z), bfhi(w1.z), bflo(w1.w), bfhi(w1.w)}; }
        v0 = v0 + e0; v1 = v1 + e1; v2 = v2 + e2; v3 = v3 + e3;
        ra[0] = (u32x4){pk_bf16(v0.x, v0.y), pk_bf16(v0.z, v0.w), pk_bf16(v1.x, v1.y), pk_bf16(v1.z, v1.w)};
        ra[1] = (u32x4){pk_bf16(v2.x, v2.y), pk_bf16(v2.z, v2.w), pk_bf16(v3.x, v3.y), pk_bf16(v3.z, v3.w)};
        const u32x4* q = (const u32x4*)(wsrc + ks * 64); rb[0] = q[0]; rb[1] = q[1];
    };
    auto store = [&](int st) {
        LAS unsigned char* pa = L + st * STG + (R * PITCH + c4 * 16) * 2; LAS unsigned char* pb = L + 2 * STG + st * STG + (R * PITCH + c4 * 16) * 2;
        *(LAS u32x4*)pa = ra[0]; *(LAS u32x4*)(pa + 16) = ra[1]; *(LAS u32x4*)pb = rb[0]; *(LAS u32x4*)(pb + 16) = rb[1];
    };
    load(0); store(0); __syncthreads();
    for (int ks = 0; ks < 64; ++ks) {
        const int st = ks & 1;
        if (ks + 1 < 64) load(ks + 1);
        LAS const unsigned char* As = L + st * STG; LAS const unsigned char* Bs = L + 2 * STG + st * STG;
#pragma unroll
        for (int s = 0; s < 2; ++s) {
            bf16x8 af[2], bfr[4];
#pragma unroll
            for (int mi = 0; mi < 2; ++mi) af[mi] = *(const LAS bf16x8*)(As + ((32 * wm + 16 * mi + r16) * PITCH + 32 * s + 8 * kq) * 2);
#pragma unroll
            for (int ni = 0; ni < 4; ++ni) bfr[ni] = *(const LAS bf16x8*)(Bs + ((64 * wn + 16 * ni + r16) * PITCH + 32 * s + 8 * kq) * 2);
#pragma unroll
            for (int mi = 0; mi < 2; ++mi)
#pragma unroll
                for (int ni = 0; ni < 4; ++ni) acc[mi][ni] = __builtin_amdgcn_mfma_f32_16x16x32_bf16(af[mi], bfr[ni], acc[mi][ni], 0, 0, 0);
        }
        if (ks + 1 < 64) store(st ^ 1);
        __syncthreads();
    }
    LAS float* HID = (LAS float*)L; LAS float* W2s = (LAS float*)(L + 67584);
#pragma unroll
    for (int mi = 0; mi < 2; ++mi)
#pragma unroll
        for (int ni = 0; ni < 4; ++ni) { const int col = 64 * wn + 16 * ni + r16;
#pragma unroll
            for (int r = 0; r < 4; ++r) HID[(32 * wm + 16 * mi + 4 * kq + r) * 132 + col] = siluf_(acc[mi][ni][r]); }
    { const f32x4* w2 = (const f32x4*)(kv ? a.cmp_w2_v : a.cmp_w2_k);
#pragma unroll
      for (int i = 0; i < 4; ++i) ((LAS f32x4*)W2s)[tid + 512 * i] = w2[tid + 512 * i]; }
    __syncthreads();
    {
        float o[16];
#pragma unroll
        for (int j = 0; j < 16; ++j) o[j] = 0.f;
        for (int n = 0; n < 128; ++n) { const float h = HID[R * 132 + n]; const LAS f32x4* wr = (const LAS f32x4*)(W2s + n * 64 + c4 * 16);
#pragma unroll
            for (int q = 0; q < 4; ++q) { const f32x4 wv = wr[q]; o[4 * q] += h * wv.x; o[4 * q + 1] += h * wv.y; o[4 * q + 2] += h * wv.z; o[4 * q + 3] += h * wv.w; } }
        if (MODE == 0) { const int sb = tl >> 2, blk = (tl & 3) * 64 + (R >> 1), g = R & 1;
            float* d = (float*)(a.ws + (kv ? WS_VCMPS : WS_KCMPS)) + ((size_t)(sb * 2 + g) * 256 + blk) * 64 + c4 * 16;
#pragma unroll
            for (int q = 0; q < 4; ++q) *(f32x4*)(d + 4 * q) = (f32x4){o[4 * q], o[4 * q + 1], o[4 * q + 2], o[4 * q + 3]}; }
        else { const int GR = tl * 128 + R, bblk = GR >> 1, g = GR & 1, b = bblk >> 7, blk = bblk & 127;
            if (kv == 0) { bf16_t* d = (bf16_t*)(a.ws + WS_KCMPP) + ((size_t)(b * 2 + g) * 128 + blk) * 64 + c4 * 16;
                *(u32x4*)d = (u32x4){pk_bf16(o[0], o[1]), pk_bf16(o[2], o[3]), pk_bf16(o[4], o[5]), pk_bf16(o[6], o[7])};
                *(u32x4*)(d + 8) = (u32x4){pk_bf16(o[8], o[9]), pk_bf16(o[10], o[11]), pk_bf16(o[12], o[13]), pk_bf16(o[14], o[15])}; }
            else { bf16_t* d = (bf16_t*)(a.ws + WS_VCMPT) + ((size_t)(b * 2 + g) * 64 + c4 * 16) * 128 + (blk & ~31) + vslot32(blk & 31);
#pragma unroll
                for (int j = 0; j < 16; ++j) d[(size_t)j * 128] = (bf16_t)(pk_bf16(o[j], 0.f) & 0xffffu); } }
    }
    __syncthreads();
}

__device__ __forceinline__ int swz_off(int row, int chunk) { return row * 128 + ((chunk ^ (row & 7)) << 4); }
constexpr int NST = 4, STB = 16384;
__device__ __forceinline__ void tile_dma(const bf16_t* Kbg, const bf16_t* Vtbg, int j, LAS unsigned char* stage, int w, int lane) {
    const int c = w * 64 + lane, row = c >> 3, sc = (c & 7) ^ (row & 7);
    __builtin_amdgcn_global_load_lds((const unsigned*)(Kbg + (size_t)(64 * j + row) * 128 + sc * 8), (LAS unsigned*)(stage + w * 1024), 16, 0, 0);
    __builtin_amdgcn_global_load_lds((const unsigned*)(Vtbg + (size_t)j * 4096 + row * 64 + sc * 8), (LAS unsigned*)(stage + 8192 + w * 1024), 16, 0, 0);
}
__device__ __forceinline__ void tile_wait(int ahead) {
    if (ahead >= 2) asm volatile("s_waitcnt vmcnt(4)" ::: "memory"); else if (ahead == 1) asm volatile("s_waitcnt vmcnt(2)" ::: "memory"); else asm volatile("s_waitcnt vmcnt(0)" ::: "memory");
}
__device__ __forceinline__ void build_xt(const Args& a, Frame& F, int off, int DMAX, int NE, int DLIM, int g) {
    const float* BT = (const float*)(a.ws + WS_BT); LAS float* d = (LAS float*)(F.lds + off);
    for (int i = F.tid; i < NE * 8; i += 512) { const int dd = DMAX - (i >> 3); d[i] = (dd < 0 || dd > DLIM) ? NEG_INF : BT[(dd > 128 ? 128 : dd) * 16 + g * 8 + (i & 7)]; }
}
template <int DMAX, bool COLSEL>
__device__ __forceinline__ void pair_tile(f32x4 (&O)[4], float& mrun, float& lrun, const bf16x8 (&Qf)[2], LAS const unsigned char* Kt, LAS const unsigned char* Vt,
                                          LAS const float* XT, int r16, int kq, bool colsel, int dbase, int hh) {
    f32x4 S[4];
#pragma unroll
    for (int m = 0; m < 4; ++m) { S[m] = (f32x4){0.f, 0.f, 0.f, 0.f};
#pragma unroll
        for (int s = 0; s < 2; ++s) { const bf16x8 kf = *(const LAS bf16x8*)(Kt + swz_off(16 * m + r16, 4 * s + kq)); S[m] = __builtin_amdgcn_mfma_f32_16x16x32_bf16(kf, Qf[s], S[m], 0, 0, 0); } }
    const int dbc = dbase < DMAX ? dbase : DMAX;
    LAS const float* bp = XT + (4 * kq - dbc + DMAX) * 8 + (hh & 7);
    const float cadd = (COLSEL && !colsel) ? NEG_INF : 0.f;
    float mx = NEG_INF;
#pragma unroll
    for (int m = 0; m < 4; ++m)
#pragma unroll
        for (int r = 0; r < 4; ++r) { float v = S[m][r] + bp[(16 * m + r) * 8]; if (COLSEL) v += cadd; S[m][r] = v; mx = fmaxf(mx, v); }
    mx = fmaxf(mx, __shfl_xor(mx, 16)); mx = fmaxf(mx, __shfl_xor(mx, 32));
    const float mnew = fmaxf(mrun, mx), msafe = (mnew == NEG_INF) ? 0.f : mnew;
    const float alpha = fexp2(mrun - msafe);
    float ps = 0.f;
#pragma unroll
    for (int m = 0; m < 4; ++m)
#pragma unroll
        for (int r = 0; r < 4; ++r) { const float p = fexp2(S[m][r] - msafe); S[m][r] = p; ps += p; }
    lrun = lrun * alpha + ps; mrun = mnew;
    if (__any(alpha != 1.f)) {
#pragma unroll
        for (int md = 0; md < 4; ++md) O[md] = O[md] * alpha; }
    bf16x8 Pf[2];
#pragma unroll
    for (int s = 0; s < 2; ++s) { const u32x4 w = (u32x4){pk_bf16(S[2 * s][0], S[2 * s][1]), pk_bf16(S[2 * s][2], S[2 * s][3]), pk_bf16(S[2 * s + 1][0], S[2 * s + 1][1]), pk_bf16(S[2 * s + 1][2], S[2 * s + 1][3])};
        Pf[s] = __builtin_bit_cast(bf16x8, w); }
#pragma unroll
    for (int md = 0; md < 4; ++md)
#pragma unroll
        for (int s = 0; s < 2; ++s) { const bf16x8 vf = *(const LAS bf16x8*)(Vt + swz_off(16 * md + r16, 4 * s + kq)); O[md] = __builtin_amdgcn_mfma_f32_16x16x32_bf16(vf, Pf[s], O[md], 0, 0, 0); }
}

template <int DMAX>
__device__ __forceinline__ void quad_tile(f32x4 (&O)[4][4], float (&mrun)[4], float (&lrun)[4], LAS const bf16x8* QL, LAS const unsigned char* Kt, LAS const unsigned char* Vt,
                                          LAS const float* XT, int r16, int kq, int dbase0, int hh) {
    bf16x8 Pf[4][2];
    {
        bf16x8 kf[4][2];
#pragma unroll
        for (int m = 0; m < 4; ++m)
#pragma unroll
            for (int s = 0; s < 2; ++s) kf[m][s] = *(const LAS bf16x8*)(Kt + swz_off(16 * m + r16, 4 * s + kq));
        LAS const float* bp3 = XT + (4 * kq - dbase0 - 6 + DMAX) * 8 + (hh & 7);
#pragma unroll
        for (int p = 0; p < 4; ++p) {
            f32x4 S[4]; float mx = NEG_INF; const bf16x8 q0 = QL[(p * 2) * 64], q1 = QL[(p * 2 + 1) * 64];
#pragma unroll
            for (int m = 0; m < 4; ++m) { S[m] = __builtin_amdgcn_mfma_f32_16x16x32_bf16(kf[m][0], q0, (f32x4){0.f, 0.f, 0.f, 0.f}, 0, 0, 0); S[m] = __builtin_amdgcn_mfma_f32_16x16x32_bf16(kf[m][1], q1, S[m], 0, 0, 0); }
#pragma unroll
            for (int m = 0; m < 4; ++m)
#pragma unroll
                for (int r = 0; r < 4; ++r) { const float v = S[m][r] + bp3[(16 * m + r + 6 - 2 * p) * 8]; S[m][r] = v; mx = fmaxf(mx, v); }
            mx = fmaxf(mx, __shfl_xor(mx, 16)); mx = fmaxf(mx, __shfl_xor(mx, 32));
            const float mnew = fmaxf(mrun[p], mx), msafe = (mnew == NEG_INF) ? 0.f : mnew;
            const float alpha = fexp2(mrun[p] - msafe);
            float ps = 0.f;
#pragma unroll
            for (int m = 0; m < 4; ++m)
#pragma unroll
                for (int r = 0; r < 4; ++r) { const float pr = fexp2(S[m][r] - msafe); S[m][r] = pr; ps += pr; }
            lrun[p] = lrun[p] * alpha + ps; mrun[p] = mnew;
            if (__any(alpha != 1.f)) {
#pragma unroll
                for (int md = 0; md < 4; ++md) O[p][md] = O[p][md] * alpha; }
#pragma unroll
            for (int s = 0; s < 2; ++s) { const u32x4 w = (u32x4){pk_bf16(S[2 * s][0], S[2 * s][1]), pk_bf16(S[2 * s][2], S[2 * s][3]), pk_bf16(S[2 * s + 1][0], S[2 * s + 1][1]), pk_bf16(S[2 * s + 1][2], S[2 * s + 1][3])};
                Pf[p][s] = __builtin_bit_cast(bf16x8, w); }
        }
    }
    __builtin_amdgcn_sched_barrier(0);
    {
        bf16x8 vf[4][2];
#pragma unroll
        for (int md = 0; md < 4; ++md)
#pragma unroll
            for (int s = 0; s < 2; ++s) vf[md][s] = *(const LAS bf16x8*)(Vt + swz_off(16 * md + r16, 4 * s + kq));
#pragma unroll
        for (int p = 0; p < 4; ++p)
#pragma unroll
            for (int md = 0; md < 4; ++md) { O[p][md] = __builtin_amdgcn_mfma_f32_16x16x32_bf16(vf[md][0], Pf[p][0], O[p][md], 0, 0, 0); O[p][md] = __builtin_amdgcn_mfma_f32_16x16x32_bf16(vf[md][1], Pf[p][1], O[p][md], 0, 0, 0); }
    }
    __builtin_amdgcn_sched_barrier(0);
}

constexpr int AT_RING = 0;
constexpr int AT_KCMP = 65536;
constexpr int AT_VCMP = 81920;
constexpr int AT_SCORE = 98304;
constexpr int AT_XT = 131072;
constexpr int WIN_XT = 65536;
constexpr int WIN_QL = 65536 + 20480;
constexpr int SEL_DMAX = 255, SEL_NE = 319, WIN_DMAX = 575, WIN_NE = 639;
static_assert(AT_XT + SEL_NE * 32 <= LDS_CTL && WIN_XT + WIN_NE * 32 <= WIN_QL && WIN_QL + 65536 <= LDS_CTL, "attention LDS map");

__device__ __forceinline__ void win_unit(const Args& a, Frame& F, int b, int g, int qb) {
    LAS unsigned char* L = F.lds; const int lane = F.lane, w = F.wave, r16 = lane & 15, kq = lane >> 4, slot = r16 >> 3, h = r16 & 7, hh = g * 8 + h;
    const bf16_t* Kbg = (const bf16_t*)(a.ws + WS_KW) + (size_t)b * SEQ * 128 + g * 64;
    const bf16_t* Vtbg = (const bf16_t*)(a.ws + WS_VWT) + (size_t)(b * 2 + g) * 128 * 4096;
    const bf16_t* Qb = (const bf16_t*)(a.ws + WS_Q);
    LAS const float* XT = (LAS const float*)(L + WIN_XT);
    const int j0 = qb >= 8 ? qb - 8 : 0;
#pragma unroll
    for (int t = 0; t < 3; ++t) if (j0 + t <= qb) tile_dma(Kbg, Vtbg, j0 + t, L + AT_RING + t * STB, w, lane);
    build_xt(a, F, WIN_XT, WIN_DMAX, WIN_NE, 512, g);
    LAS bf16x8* QL = (LAS bf16x8*)(L + WIN_QL + w * 8192) + lane;
#pragma unroll
    for (int p = 0; p < 4; ++p) { const int q = qb * 64 + w * 8 + 2 * p + slot; const bf16_t* qp = Qb + ((size_t)(b * SEQ + q)) * DM + g * 512 + h * 64 + 8 * kq;
        QL[(p * 2) * 64] = *(const bf16x8*)qp; QL[(p * 2 + 1) * 64] = *(const bf16x8*)(qp + 32); }
    f32x4 O[4][4]; float mr[4], lr[4];
#pragma unroll
    for (int p = 0; p < 4; ++p) { mr[p] = NEG_INF; lr[p] = 0.f;
#pragma unroll
        for (int md = 0; md < 4; ++md) O[p][md] = (f32x4){0.f, 0.f, 0.f, 0.f}; }
    asm volatile("s_waitcnt vmcnt(0) lgkmcnt(0)" ::: "memory");
    for (int j = j0; j <= qb; ++j) {
        tile_wait((qb - j) < 2 ? (qb - j) : 2);
        asm volatile("s_waitcnt lgkmcnt(0)" ::: "memory"); __builtin_amdgcn_s_barrier(); asm volatile("" ::: "memory");
        if (j + 3 <= qb) tile_dma(Kbg, Vtbg, j + 3, L + AT_RING + ((j - j0 + 3) % NST) * STB, w, lane);
        LAS const unsigned char* Kt = L + AT_RING + ((j - j0) % NST) * STB; LAS const unsigned char* Vt = Kt + 8192;
        quad_tile<WIN_DMAX>(O, mr, lr, QL, Kt, Vt, XT, r16, kq, 64 * (qb - j) + w * 8 + slot, hh);
    }
    bf16_t* OW = (bf16_t*)(a.ws + WS_OWIN);
#pragma unroll
    for (int p = 0; p < 4; ++p) { float lt = lr[p]; lt += __shfl_xor(lt, 16); lt += __shfl_xor(lt, 32); const float inv = lt > 0.f ? 1.f / lt : 0.f;
        const int q = qb * 64 + w * 8 + 2 * p + slot; bf16_t* d = OW + ((size_t)(b * SEQ + q)) * DM + g * 512 + h * 64 + 4 * kq;
#pragma unroll
        for (int md = 0; md < 4; ++md) { const f32x4 o = O[p][md] * inv; *(u32x2*)(d + 16 * md) = (u32x2){pk_bf16(o.x, o.y), pk_bf16(o.z, o.w)}; } }
    __syncthreads();
}

template <int NE> __device__ __forceinline__ void topk16(const unsigned (&key)[NE], unsigned long long (&sel)[NE], int lane) {
    unsigned T = 0u;
    for (int bit = 31; bit >= 0; --bit) { const unsigned cand = T | (1u << bit); int cnt = 0;
#pragma unroll
        for (int e = 0; e < NE; ++e) cnt += __popcll(__ballot(key[e] >= cand));
        if (cnt >= 16) T = cand; }
    if (T == 0u) {
#pragma unroll
        for (int e = 0; e < NE; ++e) sel[e] = __ballot(key[e] > 0u);
        return; }
    int ngt = 0;
#pragma unroll
    for (int e = 0; e < NE; ++e) ngt += __popcll(__ballot(key[e] > T));
    int need = 16 - ngt, prior = 0; const unsigned long long lt = (1ull << lane) - 1ull;
#pragma unroll
    for (int e = 0; e < NE; ++e) { const bool eq = key[e] == T; const unsigned long long em = __ballot(eq); const int rank = prior + __popcll(em & lt);
        sel[e] = __ballot(key[e] > T || (eq && rank < need)); prior += __popcll(em); }
}

__device__ __forceinline__ void nsa_unit(const Args& a, Frame& F, int b, int g, int qb) {
    LAS unsigned char* L = F.lds; const int tid = F.tid, lane = F.lane, w = F.wave, r16 = lane & 15, kq = lane >> 4, slot = r16 >> 3, h = r16 & 7, hh = g * 8 + h;
    const bf16_t* Kbg = (const bf16_t*)(a.ws + WS_KSL) + (size_t)b * SEQ * 128 + g * 64;
    const bf16_t* Vtbg = (const bf16_t*)(a.ws + WS_VSLT) + (size_t)(b * 2 + g) * 128 * 4096;
    const bf16_t* Qb = (const bf16_t*)(a.ws + WS_Q);
    LAS const float* XT = (LAS const float*)(L + AT_XT);
    LAS float* SCORE = (LAS float*)(L + AT_SCORE);
#pragma unroll
    for (int t = 0; t < 3; ++t) if (t <= qb) tile_dma(Kbg, Vtbg, t, L + AT_RING + t * STB, w, lane);
    { const u32x4* ks = (const u32x4*)((const bf16_t*)(a.ws + WS_KCMPP) + (size_t)(b * 2 + g) * 128 * 64);
      const u32x4* vs = (const u32x4*)((const bf16_t*)(a.ws + WS_VCMPT) + (size_t)(b * 2 + g) * 64 * 128);
#pragma unroll
      for (int i = 0; i < 2; ++i) { const int c = tid + 512 * i;
          *(LAS u32x4*)(L + AT_KCMP + swz_off(c >> 3, c & 7)) = ks[c];
          const int row = c >> 4, ch = c & 15; *(LAS u32x4*)(L + AT_VCMP + row * 256 + (((ch & 8) | ((ch ^ row) & 7)) << 4)) = vs[c]; } }
    build_xt(a, F, AT_XT, SEL_DMAX, SEL_NE, 1 << 30, g);
    bf16x8 Qf[4][2];
#pragma unroll
    for (int p = 0; p < 4; ++p) { const int q = qb * 64 + w * 8 + 2 * p + slot; const bf16_t* qp = Qb + ((size_t)(b * SEQ + q)) * DM + g * 512 + h * 64 + 8 * kq;
        Qf[p][0] = *(const bf16x8*)qp; Qf[p][1] = *(const bf16x8*)(qp + 32); }
    __syncthreads();
    const float* Gt = (const float*)(a.ws + WS_G);
    bf16_t* A2 = (bf16_t*)(a.ws + WS_A2);
    const int nmt = (qb + 16) >> 4;
#pragma unroll
    for (int p = 0; p < 4; ++p) {
        const int i = w * 8 + 2 * p + slot, q = qb * 64 + i;
        f32x4 S[8]; float mx = NEG_INF;
#pragma unroll
        for (int m = 0; m < 8; ++m) { S[m] = (f32x4){NEG_INF, NEG_INF, NEG_INF, NEG_INF};
            if (m < nmt) { f32x4 c = (f32x4){0.f, 0.f, 0.f, 0.f};
#pragma unroll
                for (int s = 0; s < 2; ++s) { const bf16x8 kf = *(const LAS bf16x8*)(L + AT_KCMP + swz_off(16 * m + r16, 4 * s + kq)); c = __builtin_amdgcn_mfma_f32_16x16x32_bf16(kf, Qf[p][s], c, 0, 0, 0); }
#pragma unroll
                for (int r = 0; r < 4; ++r) { const int jb = 16 * m + 4 * kq + r; const bool vis = (jb < qb) || (jb == qb && i == 63);
                    int d = 64 * (qb - jb) + i - 63; d = d < 0 ? 0 : (d > 128 ? 128 : d);
                    const float v = vis ? c[r] + XT[(SEL_DMAX - d) * 8 + h] : NEG_INF; S[m][r] = v; mx = fmaxf(mx, v); } } }
        mx = fmaxf(mx, __shfl_xor(mx, 16)); mx = fmaxf(mx, __shfl_xor(mx, 32));
        const float msafe = (mx == NEG_INF) ? 0.f : mx; float ps = 0.f;
#pragma unroll
        for (int m = 0; m < 8; ++m)
#pragma unroll
            for (int r = 0; r < 4; ++r) { const float pp = fexp2(S[m][r] - msafe); S[m][r] = pp; ps += pp; }
        ps += __shfl_xor(ps, 16); ps += __shfl_xor(ps, 32);
        const float inv = ps > 0.f ? 1.f / ps : 0.f;
#pragma unroll
        for (int m = 0; m < 8; ++m) { f32x4 pn = S[m] * inv; S[m] = pn;
            f32x4 im = pn;
#pragma unroll
            for (int r = 0; r < 4; ++r) { float v = im[r]; v += __shfl_xor(v, 1); v += __shfl_xor(v, 2); v += __shfl_xor(v, 4); im[r] = v; }
#pragma unroll
            for (int r = 0; r < 4; ++r) { const int jb = 16 * m + 4 * kq + r; const bool vis = (jb < qb) || (jb == qb && i == 63);
                im[r] = vis ? im[r] : (jb <= qb ? 2.0f : -1.0f); }
            if (h == 0) *(LAS f32x4*)(SCORE + i * 128 + 16 * m + 4 * kq) = im; }
        f32x4 oc[4];
#pragma unroll
        for (int md = 0; md < 4; ++md) oc[md] = (f32x4){0.f, 0.f, 0.f, 0.f};
#pragma unroll
        for (int s = 0; s < 4; ++s) if (2 * s < nmt) {
            const u32x4 wv = (u32x4){pk_bf16(S[2 * s][0], S[2 * s][1]), pk_bf16(S[2 * s][2], S[2 * s][3]), pk_bf16(S[2 * s + 1][0], S[2 * s + 1][1]), pk_bf16(S[2 * s + 1][2], S[2 * s + 1][3])};
            const bf16x8 pf = __builtin_bit_cast(bf16x8, wv);
#pragma unroll
            for (int md = 0; md < 4; ++md) { const int row = 16 * md + r16, ch = 4 * s + kq;
                const bf16x8 vf = *(const LAS bf16x8*)(L + AT_VCMP + row * 256 + (((ch & 8) | ((ch ^ row) & 7)) << 4));
                oc[md] = __builtin_amdgcn_mfma_f32_16x16x32_bf16(vf, pf, oc[md], 0, 0, 0); } }
        const float g0 = Gt[(size_t)(b * SEQ + q) * 48 + hh];
#pragma unroll
        for (int md = 0; md < 4; ++md) { const f32x4 o = oc[md] * g0;
            *(u32x2*)(A2 + (size_t)(b * SEQ + q) * DMIX + g * 512 + h * 64 + 4 * kq + 16 * md) = (u32x2){pk_bf16(o.x, o.y), pk_bf16(o.z, o.w)}; }
    }
    LDS_WAIT(); __builtin_amdgcn_wave_barrier(); asm volatile("" ::: "memory");
    unsigned long long mA[8], mB[8];
#pragma unroll
    for (int qq = 0; qq < 8; ++qq) { const int i = w * 8 + qq; const float sa = SCORE[i * 128 + lane], sb = SCORE[i * 128 + 64 + lane];
        unsigned key[2]; key[0] = sa >= 0.f ? __float_as_uint(sa) + 1u : 0u; key[1] = sb >= 0.f ? __float_as_uint(sb) + 1u : 0u;
        unsigned long long sel[2]; topk16<2>(key, sel, lane); mA[qq] = sel[0]; mB[qq] = sel[1]; }
    __syncthreads();
    LAS bf16x8* QL = (LAS bf16x8*)(L + AT_KCMP + w * 8192) + lane;
#pragma unroll
    for (int p = 0; p < 4; ++p) { QL[(p * 2) * 64] = Qf[p][0]; QL[(p * 2 + 1) * 64] = Qf[p][1]; }
    LDS_WAIT(); asm volatile("" ::: "memory");
    f32x4 O[4][4]; float mr[4], lr[4];
#pragma unroll
    for (int p = 0; p < 4; ++p) { mr[p] = NEG_INF; lr[p] = 0.f;
#pragma unroll
        for (int md = 0; md < 4; ++md) O[p][md] = (f32x4){0.f, 0.f, 0.f, 0.f}; }
    asm volatile("s_waitcnt vmcnt(0)" ::: "memory");
    for (int j = 0; j <= qb; ++j) {
        if (j >= 3) tile_wait((qb - j) < 2 ? (qb - j) : 2);
        asm volatile("s_waitcnt lgkmcnt(0)" ::: "memory"); __builtin_amdgcn_s_barrier(); asm volatile("" ::: "memory");
        if (j + 3 <= qb) tile_dma(Kbg, Vtbg, j + 3, L + AT_RING + ((j + 3) % NST) * STB, w, lane);
        LAS const unsigned char* Kt = L + AT_RING + (j % NST) * STB; LAS const unsigned char* Vt = Kt + 8192;
#pragma unroll
        for (int p = 0; p < 4; ++p) {
            const bool a0 = (((j < 64 ? mA[2 * p] : mB[2 * p]) >> (j & 63)) & 1ull) != 0ull, a1 = (((j < 64 ? mA[2 * p + 1] : mB[2 * p + 1]) >> (j & 63)) & 1ull) != 0ull;
            if (a0 || a1) { const int i = w * 8 + 2 * p + slot; bf16x8 qf[2]; qf[0] = QL[(p * 2) * 64]; qf[1] = QL[(p * 2 + 1) * 64];
                pair_tile<SEL_DMAX, true>(O[p], mr[p], lr[p], qf, Kt, Vt, XT, r16, kq, slot ? a1 : a0, 64 * (qb - j) + i, hh); } }
    }
    const bf16_t* OW = (const bf16_t*)(a.ws + WS_OWIN); const bf16_t* SZ = (const bf16_t*)(a.ws + WS_SZA);
#pragma unroll
    for (int p = 0; p < 4; ++p) { float lt = lr[p]; lt += __shfl_xor(lt, 16); lt += __shfl_xor(lt, 32);
        const int q = qb * 64 + w * 8 + 2 * p + slot; const size_t row = (size_t)(b * SEQ + q);
        const float g1 = Gt[row * 48 + 16 + hh], g2 = Gt[row * 48 + 32 + hh]; const float inv = lt > 0.f ? g1 / lt : 0.f;
        const int col = g * 512 + h * 64 + 4 * kq;
#pragma unroll
        for (int md = 0; md < 4; ++md) { const u32x2 ow = *(const u32x2*)(OW + row * DM + col + 16 * md), sz = *(const u32x2*)(SZ + row * DM + col + 16 * md);
            const u32x2 ocv = __builtin_nontemporal_load((const u32x2*)(A2 + row * DMIX + col + 16 * md));
            const f32x4 o = (f32x4){bflo(ocv.x), bfhi(ocv.x), bflo(ocv.y), bfhi(ocv.y)} + O[p][md] * inv + (f32x4){bflo(ow.x), bfhi(ow.x), bflo(ow.y), bfhi(ow.y)} * g2;
            const f32x4 r = o * (f32x4){bflo(sz.x), bfhi(sz.x), bflo(sz.y), bfhi(sz.y)};
            *(u32x2*)(A2 + row * DMIX + col + 16 * md) = (u32x2){pk_bf16(r.x, r.y), pk_bf16(r.z, r.w)}; } }
    __syncthreads();
}

constexpr int SU_KT = 0, SU_VT = 17408, SU_QS = 34816, SU_PW = 36864, SU_IMP = 38912, SU_BT = 47360, SU_SEL = 55616, SU_SCORE = 55808;
struct VSrc { const float* k; const float* v; bool ok; };
__device__ __forceinline__ float valu_tile(LAS const float* KT, LAS const float* VT, LAS const float* QSh, LAS float* PWh, int lane, bool ok, float bias, float& m, float& l, float& O) {
    float s = 0.f;
#pragma unroll 4
    for (int d4 = 0; d4 < 16; ++d4) { const f32x4 kk = *(const LAS f32x4*)(KT + lane * 68 + 4 * d4), qq = *(const LAS f32x4*)(QSh + 4 * d4); s += kk.x * qq.x + kk.y * qq.y + kk.z * qq.z + kk.w * qq.w; }
    s = ok ? s + bias : NEG_INF;
    const float mt = wave_max(s), mnew = fmaxf(m, mt), msafe = (mnew == NEG_INF) ? 0.f : mnew;
    const float alpha = fexp2(m - msafe), p = fexp2(s - msafe);
    l = l * alpha + wave_sum(p); m = mnew;
    PWh[lane] = p; LDS_WAIT(); __builtin_amdgcn_wave_barrier();
    float o = O * alpha;
#pragma unroll 4
    for (int k4 = 0; k4 < 16; ++k4) { const f32x4 pp = *(const LAS f32x4*)(PWh + 4 * k4);
        o += pp.x * VT[(4 * k4) * 68 + lane] + pp.y * VT[(4 * k4 + 1) * 68 + lane] + pp.z * VT[(4 * k4 + 2) * 68 + lane] + pp.w * VT[(4 * k4 + 3) * 68 + lane]; }
    O = o; LDS_WAIT(); __builtin_amdgcn_wave_barrier();
    return s;
}
struct VRegs { f32x4 k0, k1, v0, v1; };
__device__ __forceinline__ void vfetch(VRegs& r, const VSrc& s) {
    if (s.ok) { const f32x4* kp = (const f32x4*)s.k; const f32x4* vp = (const f32x4*)s.v; r.k0 = kp[0]; r.k1 = kp[1]; r.v0 = vp[0]; r.v1 = vp[1]; }
    else { r.k0 = r.k1 = r.v0 = r.v1 = (f32x4){0.f, 0.f, 0.f, 0.f}; }
}
__device__ __forceinline__ void vstore(const VRegs& r, LAS unsigned char* L, int tid) {
    LAS float* kd = (LAS float*)(L + SU_KT) + (tid >> 3) * 68 + (tid & 7) * 8; LAS float* vd = (LAS float*)(L + SU_VT) + (tid >> 3) * 68 + (tid & 7) * 8;
    *(LAS f32x4*)kd = r.k0; *(LAS f32x4*)(kd + 4) = r.k1; *(LAS f32x4*)vd = r.v0; *(LAS f32x4*)(vd + 4) = r.v1;
}
__device__ __forceinline__ void load_bt(const Args& a, Frame& F, int off) {
    const float* BT = (const float*)(a.ws + WS_BT); LAS float* d = (LAS float*)(F.lds + off);
    for (int i = F.tid; i < 129 * 16; i += 512) d[i] = BT[i];
}
__device__ __forceinline__ void sample_unit(const Args& a, Frame& F, int sb, int g, int t) {
    LAS unsigned char* L = F.lds; const int tid = F.tid, lane = F.lane, h = F.wave, hh = g * 8 + h, key = tid >> 3, c8 = tid & 7;
    const int qpos = PAST + t; const size_t row = (size_t)NPR + sb * 4 + t;
    LAS float* QSh = (LAS float*)(L + SU_QS) + h * 64; LAS float* PWh = (LAS float*)(L + SU_PW) + h * 64; LAS float* IMP = (LAS float*)(L + SU_IMP);
    LAS const float* BTl = (LAS const float*)(L + SU_BT); LAS int* SEL = (LAS int*)(L + SU_SEL); LAS float* SCORE = (LAS float*)(L + SU_SCORE);
    LAS const float* KT = (LAS const float*)(L + SU_KT); LAS const float* VT = (LAS const float*)(L + SU_VT);
    load_bt(a, F, SU_BT);
    QSh[lane] = bf2f(((const bf16_t*)(a.ws + WS_Q))[row * DM + g * 512 + h * 64 + lane]);
    VRegs vr; VSrc src;
    const float* kc = (const float*)(a.ws + WS_KCMPS) + (size_t)(sb * 2 + g) * 256 * 64; const float* vc = (const float*)(a.ws + WS_VCMPS) + (size_t)(sb * 2 + g) * 256 * 64;
    float mc = NEG_INF, lc = 0.f, oc = 0.f, sc[4];
    src.k = kc + (size_t)key * 64 + c8 * 8; src.v = vc + (size_t)key * 64 + c8 * 8; src.ok = true; vfetch(vr, src);
    __syncthreads();
#pragma unroll
    for (int tl = 0; tl < 4; ++tl) {
        vstore(vr, L, tid); __syncthreads();
        if (tl < 3) { src.k = kc + (size_t)(64 * (tl + 1) + key) * 64 + c8 * 8; src.v = vc + (size_t)(64 * (tl + 1) + key) * 64 + c8 * 8; vfetch(vr, src); }
        int d = qpos - (64 * (64 * tl + lane) + 63); d = d > 128 ? 128 : d;
        sc[tl] = valu_tile(KT, VT, QSh, PWh, lane, true, BTl[d * 16 + hh], mc, lc, oc);
        __syncthreads();
    }
    { const float inv = 1.f / lc;
#pragma unroll
      for (int tl = 0; tl < 4; ++tl) IMP[h * 264 + 64 * tl + lane] = fexp2(sc[tl] - mc) * inv;
      oc *= inv; }
    __syncthreads();
    if (tid < 256) { float s = 0.f;
#pragma unroll
        for (int hq = 0; hq < 8; ++hq) s += IMP[hq * 264 + tid]; SCORE[tid] = s; }
    if (tid == 256) SCORE[256] = 2.0f;
    __syncthreads();
    if (h == 0) {
        unsigned keyv[5];
#pragma unroll
        for (int e = 0; e < 4; ++e) { const float s = SCORE[64 * e + lane]; keyv[e] = s >= 0.f ? __float_as_uint(s) + 1u : 0u; }
        keyv[4] = (lane == 0) ? __float_as_uint(SCORE[256]) + 1u : 0u;
        unsigned long long sel[5]; topk16<5>(keyv, sel, lane);
        int base = 0;
#pragma unroll
        for (int e = 0; e < 5; ++e) { const bool on = (sel[e] >> lane) & 1ull; const int pos = base + __popcll(sel[e] & ((1ull << lane) - 1ull)); if (on && pos < 16) SEL[pos] = 64 * e + lane; base += __popcll(sel[e]); }
        if (lane == 0) SEL[16] = base < 16 ? base : 16;
    }
    __syncthreads();
    const int nsel = SEL[16];
    float ms = NEG_INF, ls = 0.f, os = 0.f;
    auto sel_src = [&](int n) { const int idx = SEL[n]; VSrc s;
        if (idx < 256) { const int page = a.page_table[sb * 128 + (idx >> 1)]; const size_t off = (((size_t)page * 128 + (idx & 1) * 64 + key) * 2 + g) * 64 + c8 * 8; s.k = a.cache_k_slc + off; s.v = a.cache_v_slc + off; s.ok = true; }
        else { const size_t off = ((size_t)(sb * 4 + (key & 3)) * 2 + g) * 64 + c8 * 8; s.k = a.out + O_SKC + 2 * SZ_SKV + off; s.v = a.out + O_SKC + 3 * SZ_SKV + off; s.ok = key < 4; }
        return s; };
    if (nsel > 0) { src = sel_src(0); vfetch(vr, src); }
    for (int n = 0; n < nsel; ++n) {
        vstore(vr, L, tid); __syncthreads();
        const int idx = SEL[n];
        if (n + 1 < nsel) { src = sel_src(n + 1); vfetch(vr, src); }
        int d = qpos - (64 * idx + lane); const bool ok = d >= 0; d = d < 0 ? 0 : (d > 128 ? 128 : d);
        (void)valu_tile(KT, VT, QSh, PWh, lane, ok, BTl[d * 16 + hh], ms, ls, os);
        __syncthreads();
    }
    float mw = NEG_INF, lw = 0.f, ow = 0.f;
    auto win_src = [&](int n) { VSrc s;
        if (n < 8) { const size_t off = (((size_t)sb * 512 + 64 * n + key) * 2 + g) * 64 + c8 * 8; s.k = a.cache_k_win + off; s.v = a.cache_v_win + off; s.ok = true; }
        else { const size_t off = (((size_t)sb * 512 + 508 + (key & 3)) * 2 + g) * 64 + c8 * 8; s.k = a.out + O_SKW + off; s.v = a.out + O_SKW + SZ_SW + off; s.ok = key < 4; }
        return s; };
    src = win_src(0); vfetch(vr, src);
    for (int n = 0; n < 9; ++n) {
        vstore(vr, L, tid); __syncthreads();
        if (n + 1 < 9) { src = win_src(n + 1); vfetch(vr, src); }
        int d; bool ok;
        if (n < 8) { const int r = 64 * n + lane; d = 512 + t - r; ok = r >= t; } else { d = t - lane; ok = lane <= t; }
        d = d < 0 ? 0 : (d > 128 ? 128 : d);
        (void)valu_tile(KT, VT, QSh, PWh, lane, ok, BTl[d * 16 + hh], mw, lw, ow);
        __syncthreads();
    }
    const float* Gt = (const float*)(a.ws + WS_G) + row * 48;
    const float o = Gt[hh] * oc + Gt[16 + hh] * (ls > 0.f ? os / ls : 0.f) + Gt[32 + hh] * (lw > 0.f ? ow / lw : 0.f);
    const int col = g * 512 + h * 64 + lane;
    const float sz = bf2f(((const bf16_t*)(a.ws + WS_SZA))[row * DM + col]);
    ((bf16_t*)(a.ws + WS_A2))[row * DMIX + col] = (bf16_t)(pk_bf16(o * sz, 0.f) & 0xffffu);
    __syncthreads();
}

constexpr int NPHASE = 7;
__global__ void __launch_bounds__(512, 2) fwd(Args a) {
    extern __shared__ __attribute__((aligned(16))) unsigned char lds_raw[];
    Frame F; F.lds = (LAS unsigned char*)lds_raw; F.tid = threadIdx.x; F.lane = F.tid & 63; F.wave = __builtin_amdgcn_readfirstlane(F.tid >> 6); F.G = gridDim.x; F.bid = blockIdx.x;
    for (int u = F.tid; u < (LDS_BYTES - LDS_CTL) / 4; u += 512) ((LAS unsigned*)(F.lds + LDS_CTL))[u] = 0u;
    __syncthreads();
    unsigned* ctl = (unsigned*)(a.ws + WS_CTL);
    XcdBarrier bar = xcd_barrier_post(ctl + 4096, (volatile LAS unsigned*)(F.lds + LDS_CTL));
    const int lo = a.ph_lo, hi = a.ph_hi;
#define IN(k) (lo <= (k) && (k) < hi)
#define SEAM(k) do { if (IN(k) && IN((k) + 1)) xcd_barrier(bar); } while (0)
    const int vcu = (F.G % 8 == 0) ? (F.bid % 8) * (F.G / 8) + F.bid / 8 : F.bid;
    if (IN(0)) { p0a(a, F); }
    SEAM(0);
    if (IN(1)) {
        p0b_rows(a, F);
        for (int u = F.bid; u < 256; u += F.G) compress_unit<0>(a, F, u >> 7, u & 127);
    }
    SEAM(1);
    if (IN(2)) {
        pg8::Gemm g{(const bf16_t*)(a.ws + WS_H), (const bf16_t*)(a.ws + WS_WINT), MROWS, NIN_PAD, DM};
        pg8::StaticOrder S; S.init(MROWS, NIN_PAD, F.G, F.bid);
        EpiIn E{a.out, a.ws};
        pg8::gemm_phase<EpiIn, pg8::StaticOrder, true, true>(F.lds, g, S, E);
    }
    SEAM(2);
    if (IN(3)) {
        for (int u = F.bid; u < 16; u += F.G) compress_unit<1>(a, F, u >> 3, u & 7);
        for (int u = vcu; u < 256; u += F.G) sample_unit(a, F, u >> 3, (u >> 2) & 1, u & 3);
        for (int u = vcu; u < 1024; u += F.G) { const int v = u & 255, k = u >> 8, s = v & 31; const int qb = k == 0 ? s : (k == 1 ? 63 - s : (k == 2 ? 64 + s : 127 - s));
            win_unit(a, F, v >> 6, (v >> 5) & 1, qb); }
        conv_rows(a, F); a2_zero_pad(a, F);
    }
    SEAM(3);
    if (IN(4)) {
        for (int u = vcu; u < 1024; u += F.G) { const int v = u & 255, k = u >> 8, s = v & 31; const int qb = k == 0 ? s : (k == 1 ? 63 - s : (k == 2 ? 64 + s : 127 - s));
            nsa_unit(a, F, v >> 6, (v >> 5) & 1, qb); }
    }
    SEAM(4);
    if (IN(5)) {
        pg8::Gemm g{(const bf16_t*)(a.ws + WS_A2), (const bf16_t*)(a.ws + WS_WOUTT), MROWS, DM, DMIX};
        pg8::StaticOrder S; S.init(MROWS, DM, F.G, F.bid);
        EpiOut E{a.out, a.ws, a.x_prompt, a.x_sample};
        pg8::gemm_phase<EpiOut, pg8::StaticOrder, true, true>(F.lds, g, S, E);
    }
    SEAM(5);
    if (IN(6)) { p5_rows(a, F); }
#undef IN
#undef SEAM
}

#ifndef MK_PER_PHASE
#define MK_PER_PHASE 0
#endif
extern "C" void kernel_launch(void* const* d_in, const int* in_sizes, int n_in, void* d_out, int out_size, void* d_ws, size_t ws_size, hipStream_t stream) {
    static int grid = 0;
    if (grid == 0) {
        if (n_in != 26 || (size_t)out_size != O_END || ws_size < WS_END) { fprintf(stderr, "kernel_launch: unexpected shapes: n_in %d out %d ws %zu\n", n_in, out_size, ws_size); grid = -1; return; }
        int dev = 0, cus = 0, per_cu = 0;
        if (hipGetDevice(&dev) != hipSuccess || hipDeviceGetAttribute(&cus, hipDeviceAttributeMultiprocessorCount, dev) != hipSuccess) { grid = -1; return; }
        if (hipFuncSetAttribute((const void*)fwd, hipFuncAttributeMaxDynamicSharedMemorySize, LDS_BYTES) != hipSuccess) { fprintf(stderr, "kernel_launch: hipFuncSetAttribute failed\n"); grid = -1; return; }
        if (hipOccupancyMaxActiveBlocksPerMultiprocessor(&per_cu, (const void*)fwd, 512, LDS_BYTES) != hipSuccess || per_cu < 1) { fprintf(stderr, "kernel_launch: occupancy query says %d\n", per_cu); }
        (void)hipGetLastError();
        grid = cus;
    }
    if (grid < 0) return;
    (void)hipMemsetAsync((char*)d_ws + WS_CTL, 0, CTL_ZERO_BYTES, stream);
    Args a{};
    a.x_prompt = (const float*)d_in[0]; a.x_sample = (const float*)d_in[1];
    a.cache_k_cmp = (const float*)d_in[2]; a.cache_v_cmp = (const float*)d_in[3]; a.cache_k_slc = (const float*)d_in[4]; a.cache_v_slc = (const float*)d_in[5];
    a.cache_k_win = (const float*)d_in[6]; a.cache_v_win = (const float*)d_in[7]; a.state_conv = (const float*)d_in[8]; a.page_table = (const int*)d_in[9];
    a.c_prompt = (const float*)d_in[10]; a.c_sample = (const float*)d_in[11]; a.ada_w = (const float*)d_in[12]; a.ada_b = (const float*)d_in[13]; a.norm_g = (const float*)d_in[14]; a.w_in = (const float*)d_in[15];
    a.cmp_pe_k = (const float*)d_in[16]; a.cmp_w1_k = (const float*)d_in[17]; a.cmp_w2_k = (const float*)d_in[18]; a.cmp_pe_v = (const float*)d_in[19]; a.cmp_w1_v = (const float*)d_in[20]; a.cmp_w2_v = (const float*)d_in[21];
    a.conv_w = (const float*)d_in[22]; a.w_out = (const float*)d_in[23]; a.rel_bias = (const float*)d_in[24]; a.final_g = (const float*)d_in[25];
    a.out = (float*)d_out; a.ws = (unsigned char*)d_ws;
#if MK_PER_PHASE
    for (int p = 0; p < NPHASE; ++p) { a.ph_lo = p; a.ph_hi = p + 1; hipLaunchKernelGGL(fwd, dim3(grid), dim3(512), LDS_BYTES, stream, a); }
#else
    a.ph_lo = 0; a.ph_hi = NPHASE;
    hipLaunchKernelGGL(fwd, dim3(grid), dim3(512), LDS_BYTES, stream, a);
#endif
#ifdef PROBE_REPEAT_PHASE
    a.ph_lo = PROBE_REPEAT_PHASE; a.ph_hi = PROBE_REPEAT_PHASE + 1;
    hipLaunchKernelGGL(fwd, dim3(grid), dim3(512), LDS_BYTES, stream, a);
#endif
    const hipError_t le = hipPeekAtLastError();
    if (le != hipSuccess) fprintf(stderr, "kernel_launch: launch failed: %s\n", hipGetErrorName(le));
}
```

```cpp
#include <hip/hip_runtime.h>
#include <cstdio>
#include <cstdint>

#define LAS __attribute__((address_space(3)))
#define GAS __attribute__((address_space(1)))
typedef unsigned short bf16_t;
typedef short bf16x8 __attribute__((ext_vector_type(8)));
typedef float f32x4 __attribute__((ext_vector_type(4)));
typedef unsigned u32x4 __attribute__((ext_vector_type(4)));
typedef unsigned u32x2 __attribute__((ext_vector_type(2)));

constexpr int DM = 1024, SEQ = 8192, NB = 4, DB = 32, DS = 4, PAST = 16384;
constexpr int NPR = NB * SEQ;
constexpr int NSR = DB * DS;
constexpr int MROWS = 33024;
constexpr int DIN = 6960, NIN_PAD = 7168, DMIX = 2048;
constexpr int C_Q = 0, C_KV = 1024, C_G = 1792, C_HC = 1840, C_BC = 2864, C_CC = 3888, C_ZA = 4912, C_ZC = 5936;
constexpr float LOG2E = 1.4426950408889634f;
constexpr float QSCALE = 0.125f * LOG2E;
constexpr float EPS = 1e-6f;
constexpr float NEG_INF = -__builtin_inff();

constexpr size_t O_YP = 0;
constexpr size_t O_YS = O_YP + (size_t)NPR * DM;
constexpr size_t O_PKC = O_YS + (size_t)NSR * DM;
constexpr size_t SZ_PKV = (size_t)NPR * 128;
constexpr size_t O_PKW = O_PKC + 4 * SZ_PKV;
constexpr size_t SZ_PW = (size_t)NB * 512 * 128;
constexpr size_t O_PCV = O_PKW + 2 * SZ_PW;
constexpr size_t O_SKC = O_PCV + (size_t)NB * 2 * 1024;
constexpr size_t SZ_SKV = (size_t)NSR * 128;
constexpr size_t O_SKW = O_SKC + 4 * SZ_SKV;
constexpr size_t SZ_SW = (size_t)DB * 512 * 128;
constexpr size_t O_SCV = O_SKW + 2 * SZ_SW;
constexpr size_t O_END = O_SCV + (size_t)DB * 2 * 1024;
static_assert(O_END == 55320576, "output size");

constexpr size_t MiB = 1u << 20;
constexpr size_t WS_CTL = 0, CTL_ZERO_BYTES = 1 * MiB;
constexpr size_t WS_MOD = 1 * MiB;
constexpr size_t WS_BT = 1 * MiB + 512 * 1024;
constexpr size_t WS_B1 = WS_BT + 16384;
constexpr size_t WS_WINT = 2 * MiB;
constexpr size_t WS_WOUTT = 18 * MiB;
constexpr size_t WS_W1T = 22 * MiB;
constexpr size_t WS_KCMPP = 24 * MiB;
constexpr size_t WS_VCMPT = 24 * MiB + 512 * 1024;
constexpr size_t WS_KCMPS = 25 * MiB;
constexpr size_t WS_VCMPS = 29 * MiB;
constexpr size_t WS_G = 33 * MiB;
constexpr size_t WS_RSQ = 40 * MiB;
constexpr size_t WS_H = 48 * MiB;
constexpr size_t WS_Q = 114 * MiB;
constexpr size_t WS_SZA = 179 * MiB;
constexpr size_t WS_U = 244 * MiB;
constexpr size_t WS_BCZ = 309 * MiB;
constexpr size_t WS_OWIN = 374 * MiB;
constexpr size_t WS_A2 = 439 * MiB;
constexpr size_t WS_KC = 568 * MiB;
constexpr size_t WS_VC = 576 * MiB, WS_KSL = 584 * MiB, WS_KW = 592 * MiB, WS_VSLT = 600 * MiB, WS_VWT = 608 * MiB;
constexpr size_t WS_END = 616 * MiB;

constexpr int LDS_CTL = 153600;
constexpr int LDS_BYTES = 153600 + 1024;

__device__ __forceinline__ unsigned pk_bf16(float lo, float hi) { unsigned r; asm("v_cvt_pk_bf16_f32 %0, %1, %2" : "=v"(r) : "v"(lo), "v"(hi)); return r; }
__device__ __forceinline__ float bf2f(unsigned short b) { return __uint_as_float(((unsigned)b) << 16); }
__device__ __forceinline__ float bflo(unsigned w) { return __uint_as_float(w << 16); }
__device__ __forceinline__ float bfhi(unsigned w) { return __uint_as_float(w & 0xffff0000u); }
__device__ __forceinline__ float fexp2(float x) { return __builtin_amdgcn_exp2f(x); }
__device__ __forceinline__ float frcp(float x) { return __builtin_amdgcn_rcpf(x); }
__device__ __forceinline__ float sigmoidf_(float x) { return frcp(1.f + fexp2(-LOG2E * x)); }
__device__ __forceinline__ float siluf_(float x) { return x * sigmoidf_(x); }
__device__ __forceinline__ float wave_sum(float v) {
#pragma unroll
    for (int o = 1; o < 64; o <<= 1) v += __shfl_xor(v, o);
    return v;
}
__device__ __forceinline__ float wave_max(float v) {
#pragma unroll
    for (int o = 1; o < 64; o <<= 1) v = fmaxf(v, __shfl_xor(v, o));
    return v;
}

__device__ __forceinline__ float xmax_16_32(float m) {
    auto a = __builtin_amdgcn_permlane16_swap(__float_as_uint(m), __float_as_uint(m), false, false); m = fmaxf(__uint_as_float(a[0]), __uint_as_float(a[1]));
    auto b = __builtin_amdgcn_permlane32_swap(__float_as_uint(m), __float_as_uint(m), false, false); return fmaxf(__uint_as_float(b[0]), __uint_as_float(b[1]));
}
__device__ __forceinline__ float xsum_16_32(float m) {
    auto a = __builtin_amdgcn_permlane16_swap(__float_as_uint(m), __float_as_uint(m), false, false); m = __uint_as_float(a[0]) + __uint_as_float(a[1]);
    auto b = __builtin_amdgcn_permlane32_swap(__float_as_uint(m), __float_as_uint(m), false, false); return __uint_as_float(b[0]) + __uint_as_float(b[1]);
}
__device__ __forceinline__ float dpp_sum8(float v) {
    v += __uint_as_float(__builtin_amdgcn_update_dpp(0, __float_as_uint(v), 0xB1, 0xf, 0xf, false));
    v += __uint_as_float(__builtin_amdgcn_update_dpp(0, __float_as_uint(v), 0x4E, 0xf, 0xf, false));
    v += __uint_as_float(__builtin_amdgcn_update_dpp(0, __float_as_uint(v), 0x141, 0xf, 0xf, false));
    return v;
}
#define LDS_WAIT() asm volatile("s_waitcnt lgkmcnt(0)" ::: "memory")
#define VM_WAIT() asm volatile("s_waitcnt vmcnt(0)" ::: "memory")

#define XB_TMO      128
#define XB_XCNT(j)  (256  + 64 * (j))
#define XB_XSUB(j)  (1280 + 64 * (j))
#define XB_XGEN(j)  (2304 + 64 * (j))
#define XB_TOP      3328
#define XB_TOPGEN   3392
#define XCD_BAR_WORDS 3456
#define XB_SPIN_CAP (1u << 18)
__device__ __forceinline__ unsigned xb_ld(unsigned* p)              { return __hip_atomic_load(p, __ATOMIC_RELAXED, __HIP_MEMORY_SCOPE_AGENT); }
__device__ __forceinline__ unsigned xb_add(unsigned* p, unsigned v) { return __hip_atomic_fetch_add(p, v, __ATOMIC_RELAXED, __HIP_MEMORY_SCOPE_AGENT); }
__device__ __forceinline__ unsigned xb_xcc_id() { return (unsigned)__builtin_amdgcn_s_getreg((3 << 11) | 20) & 0xFu; }
#define XB_SPIN(cond, bar) do { unsigned _sp = 0; while (cond) { __builtin_amdgcn_s_sleep(1); \
    if ((++_sp & 255u) == 0u) { if (xb_ld(&(bar)[XB_TMO])) break; if (_sp > XB_SPIN_CAP) { atomicAdd(&(bar)[XB_TMO], 1u); break; } } } } while (0)
struct XcdBarrier { unsigned* bar; unsigned x; volatile LAS unsigned* st; };
__device__ __forceinline__ XcdBarrier xcd_barrier_post(unsigned* bar, volatile LAS unsigned* st) {
    XcdBarrier b; b.bar = bar; b.x = xb_xcc_id(); b.st = st;
    if (threadIdx.x == 0) (void)xb_add(&bar[XB_XCNT(b.x)], 1u);
    return b;
}
__device__ __forceinline__ void xcd_barrier_complete(unsigned* bar, unsigned x, unsigned& nloc, unsigned& nx) {
    const unsigned G = gridDim.x * gridDim.y * gridDim.z;
    unsigned sum, cnt, mine, sp = 0u;
    for (;;) {
        sum = 0u; cnt = 0u; mine = 0u;
#pragma unroll
        for (unsigned j = 0; j < 16; ++j) { const unsigned c = xb_ld(&bar[XB_XCNT(j)]); sum += c; cnt += (c > 0u) ? 1u : 0u; mine = (j == x) ? c : mine; }
        if (sum == G) break;
        __builtin_amdgcn_s_sleep(1);
        if ((++sp & 255u) == 0u) { if (xb_ld(&bar[XB_TMO])) break; if (sp > XB_SPIN_CAP) { atomicAdd(&bar[XB_TMO], 1u); break; } }
    }
    nloc = mine > 0u ? mine : 1u; nx = cnt > 0u ? cnt : 1u;
}
__device__ __forceinline__ void xcd_barrier(const XcdBarrier& b) {
    asm volatile("s_waitcnt vmcnt(0)" ::: "memory");
    __syncthreads();
    if (threadIdx.x == 0) {
        unsigned* bar = b.bar;
        __builtin_amdgcn_s_waitcnt(0);
        unsigned nloc = b.st[0], nx = b.st[1];
        if (nloc == 0u) { xcd_barrier_complete(bar, b.x, nloc, nx); b.st[0] = nloc; b.st[1] = nx; }
        const unsigned old = xb_add(&bar[XB_XSUB(b.x)], 1u);
        const unsigned gen = old / nloc;
        if (old + 1u == (gen + 1u) * nloc) {
            __builtin_amdgcn_fence(__ATOMIC_RELEASE, "agent");
            asm volatile("s_waitcnt vmcnt(0)" ::: "memory");
            const unsigned og = xb_add(&bar[XB_TOP], 1u);
            const unsigned tg = og / nx;
            if (og + 1u == (tg + 1u) * nx) xb_add(&bar[XB_TOPGEN], 1u);
            else XB_SPIN(xb_ld(&bar[XB_TOPGEN]) == tg, bar);
            __builtin_amdgcn_fence(__ATOMIC_ACQUIRE, "agent");
            xb_add(&bar[XB_XGEN(b.x)], 1u);
            asm volatile("s_waitcnt vmcnt(0)" ::: "memory");
        } else {
            XB_SPIN(xb_ld(&bar[XB_XGEN(b.x)]) == gen, bar);
            __builtin_amdgcn_fence(__ATOMIC_ACQUIRE, "agent");
            asm volatile("s_waitcnt vmcnt(0)" ::: "memory");
        }
    }
    __syncthreads();
}

namespace pg8 {
constexpr int BM = 256, BK = 64, HALF = 128, HTB = HALF * BK * 2, STAGE_BYTES = 8 * HTB, NXCD = 8, WGM = 8;
__host__ __device__ __forceinline__ int lds_byte(int r, int c) { const int st = (r >> 4) * 2 + (c >> 5), rr = r & 15, cc = c & 31, ob = rr * 64 + cc * 2; return st * 1024 + (ob ^ (((ob >> 9) & 1) << 5)); }
__host__ __device__ __forceinline__ void stage_rc(int b, int& R, int& C) { const int st = b / 1024, sb = b % 1024, swz = sb ^ (((sb >> 9) & 1) << 5); R = (st >> 1) * 16 + swz / 64; C = (st & 1) * 32 + (swz % 64) / 2; }
struct Unit { int pm, pn; };
struct Gemm { const bf16_t* A; const bf16_t* Bt; int M, N, K; };
struct StaticOrder {
    int nM, nN, nwg, G, c;
    __host__ __device__ void init(int M, int N, int G_, int c_) { nM = M / BM; nN = N / BM; nwg = nM * nN; G = G_; c = c_; }
    __host__ __device__ bool next(int i, Unit& u) const {
        const long L = (long)i * G + c; if (L >= nwg) return false;
        int wgid = (int)L; { const int q = nwg / NXCD, r = nwg % NXCD, xcd = wgid % NXCD, off = wgid / NXCD; wgid = (xcd < r ? xcd * (q + 1) : r * (q + 1) + (xcd - r) * q) + off; }
        const int nig = WGM * nN, gid = wgid / nig, fm = gid * WGM, gsz = (nM - fm) < WGM ? (nM - fm) : WGM;
        u.pm = fm + ((wgid % nig) % gsz); u.pn = (wgid % nig) / gsz; return true;
    }
    __device__ __forceinline__ void a_ready(const Unit&) const {}
    __device__ __forceinline__ void done(const Unit&) const {}
};
template <class Epi, class Sched, bool ALIGN_EPI = false, bool SP2 = false>
__device__ __forceinline__ void gemm_phase(LAS unsigned char* lds, const Gemm g, const Sched& S, const Epi& E) {
    const int tid = threadIdx.x, wid = __builtin_amdgcn_readfirstlane(tid >> 6), lane = tid & 63, wr = wid >> 2, wc = wid & 3, fr = lane & 15, fq = lane >> 4;
    const int K = g.K, nt = K / BK;
    unsigned voffA[2], voffB[2];
#pragma unroll
    for (int i = 0; i < 2; ++i) { int R, C; stage_rc(tid * 16 + i * 8192, R, C); voffA[i] = (unsigned)(R * K + C) * 2u; voffB[i] = (unsigned)(R * K + C) * 2u; }
    const size_t kstep = (size_t)(BK * 2);
    const size_t hstep = (size_t)HALF * K * 2;
    const size_t tstep = 2 * hstep;
    const unsigned ldsw = (unsigned)wid * 1024u;
    const int aoff = lds_byte(wr * 64 + fr, fq * 8), boff = lds_byte(wc * 32 + fr, fq * 8);
#define PG8_SA(b, h) (((b) * 2 + (h)) * HTB)
#define PG8_SB(b, h) ((4 + (b) * 2 + (h)) * HTB)
#define PG8_STAGE(bufoff, gbase, voff) do { _Pragma("unroll") for (int _i = 0; _i < 2; ++_i) \
        __builtin_amdgcn_global_load_lds((const unsigned*)((const char*)(gbase) + (voff)[_i]), (LAS unsigned*)(lds + (bufoff) + ldsw + _i * 8192), 16, 0, 0); } while (0)
#define PG8_LDA(dst, b, h) do { _Pragma("unroll") for (int m = 0; m < 4; ++m) _Pragma("unroll") for (int k = 0; k < 2; ++k) dst[m][k] = *(const LAS bf16x8*)(lds + PG8_SA(b, h) + aoff + m * 2048 + k * 1024); } while (0)
#define PG8_LDB(dst, b, h) do { _Pragma("unroll") for (int n = 0; n < 2; ++n) _Pragma("unroll") for (int k = 0; k < 2; ++k) dst[n][k] = *(const LAS bf16x8*)(lds + PG8_SB(b, h) + boff + n * 2048 + k * 1024); } while (0)
#define PG8_MMA(ai, bj, At, Bt) do { __builtin_amdgcn_s_setprio(1); _Pragma("unroll") for (int m = 0; m < 4; ++m) _Pragma("unroll") for (int n = 0; n < 2; ++n) _Pragma("unroll") for (int k = 0; k < 2; ++k) \
        acc[ai][bj][m][n] = __builtin_amdgcn_mfma_f32_16x16x32_bf16(Bt[n][k], At[m][k], acc[ai][bj][m][n], 0, 0, 0); __builtin_amdgcn_s_setprio(0); } while (0)
#define PG8_WAIT_V(n) asm volatile("s_waitcnt vmcnt(" #n ")" ::: "memory")
#define PG8_WAIT_L(n) asm volatile("s_waitcnt lgkmcnt(" #n ")" ::: "memory")
#define PG8_BAR __builtin_amdgcn_s_barrier()
#define PG8_SCHED __builtin_amdgcn_sched_barrier(0)
    Unit cur, nxt; int ui = 0;
    if (!S.next(0, cur)) return;
    f32x4 acc[2][2][4][2];
#pragma unroll
    for (int a = 0; a < 2; ++a)
#pragma unroll
        for (int b = 0; b < 2; ++b)
#pragma unroll
            for (int m = 0; m < 4; ++m)
#pragma unroll
                for (int n = 0; n < 2; ++n) acc[a][b][m][n] = (f32x4){0.f, 0.f, 0.f, 0.f};
    bf16x8 At[4][2], B0[2][2], B1[2][2];
    const char* cA = (const char*)g.A + (size_t)cur.pm * tstep; const char* cB = (const char*)g.Bt + (size_t)cur.pn * tstep;
    S.a_ready(cur);
    if constexpr (SP2) {
        PG8_STAGE(PG8_SB(0, 0), cB, voffB); PG8_STAGE(PG8_SB(0, 1), cB + hstep, voffB); PG8_STAGE(PG8_SA(0, 0), cA, voffA); PG8_STAGE(PG8_SA(0, 1), cA + hstep, voffA);
        if (wr == 1) PG8_BAR;
        PG8_WAIT_V(2); PG8_BAR;
        PG8_STAGE(PG8_SB(1, 0), cB + kstep, voffB); PG8_STAGE(PG8_SA(1, 0), cA + kstep, voffA); PG8_STAGE(PG8_SB(1, 1), cB + hstep + kstep, voffB);
        PG8_WAIT_V(6); PG8_BAR;
    } else {
        PG8_STAGE(PG8_SB(0, 0), cB, voffB); PG8_STAGE(PG8_SA(0, 0), cA, voffA); PG8_STAGE(PG8_SB(0, 1), cB + hstep, voffB); PG8_STAGE(PG8_SA(0, 1), cA + hstep, voffA);
        if (wr == 1) PG8_BAR;
        PG8_WAIT_V(4); PG8_BAR;
        PG8_STAGE(PG8_SB(1, 0), cB + kstep, voffB); PG8_STAGE(PG8_SA(1, 0), cA + kstep, voffA); PG8_STAGE(PG8_SB(1, 1), cB + hstep + kstep, voffB);
        PG8_WAIT_V(6); PG8_BAR;
    }
    for (;;) {
        const bool has_next = S.next(ui + 1, nxt);
        const char* nA = has_next ? (const char*)g.A + (size_t)nxt.pm * tstep : cA; const char* nB = has_next ? (const char*)g.Bt + (size_t)nxt.pn * tstep : cB;
        for (int t = 0; t < nt; t += 2) {
            const bool last = (t == nt - 2);
            const char* a1 = cA + (size_t)(t + 1) * kstep;
            const char* a2 = last ? nA : cA + (size_t)(t + 2) * kstep; const char* b2 = last ? nB : cB + (size_t)(t + 2) * kstep;
            const char* a3 = a2 + kstep; const char* b3 = b2 + kstep;
            if (last && has_next) S.a_ready(nxt);
            if constexpr (SP2) {
            PG8_LDB(B0, 0, 0); PG8_LDB(B1, 0, 1); PG8_SCHED; PG8_LDA(At, 0, 0); PG8_STAGE(PG8_SA(1, 1), a1 + hstep, voffA);
            PG8_WAIT_V(8); PG8_WAIT_L(0); PG8_BAR; PG8_MMA(0, 0, At, B0); PG8_MMA(0, 1, At, B1); PG8_BAR; PG8_SCHED;
            PG8_LDA(At, 0, 1); PG8_STAGE(PG8_SB(0, 0), b2, voffB); PG8_STAGE(PG8_SB(0, 1), b2 + hstep, voffB); PG8_STAGE(PG8_SA(0, 0), a2, voffA);
            PG8_WAIT_V(8); PG8_WAIT_L(0); PG8_BAR; PG8_MMA(1, 0, At, B0); PG8_MMA(1, 1, At, B1); PG8_BAR; PG8_SCHED;
            PG8_LDB(B0, 1, 0); PG8_LDB(B1, 1, 1); PG8_SCHED; PG8_LDA(At, 1, 0); PG8_STAGE(PG8_SA(0, 1), a2 + hstep, voffA);
            PG8_WAIT_V(8); PG8_WAIT_L(0); PG8_BAR; PG8_MMA(0, 0, At, B0); PG8_MMA(0, 1, At, B1); PG8_BAR; PG8_SCHED;
            PG8_LDA(At, 1, 1); PG8_STAGE(PG8_SB(1, 0), b3, voffB); PG8_STAGE(PG8_SB(1, 1), b3 + hstep, voffB); PG8_STAGE(PG8_SA(1, 0), a3, voffA);
            PG8_WAIT_V(8); PG8_WAIT_L(0); PG8_BAR; PG8_MMA(1, 0, At, B0); PG8_MMA(1, 1, At, B1); PG8_BAR; PG8_SCHED;
            } else {
            PG8_LDB(B0, 0, 0); PG8_SCHED; PG8_LDA(At, 0, 0); PG8_STAGE(PG8_SA(1, 1), a1 + hstep, voffA);
            PG8_WAIT_L(8); PG8_BAR; PG8_WAIT_L(0); PG8_MMA(0, 0, At, B0); PG8_BAR; PG8_SCHED;
            PG8_LDB(B1, 0, 1); PG8_STAGE(PG8_SB(0, 0), b2, voffB);
            PG8_BAR; PG8_WAIT_L(0); PG8_MMA(0, 1, At, B1); PG8_BAR;
            PG8_LDA(At, 0, 1); PG8_STAGE(PG8_SA(0, 0), a2, voffA);
            PG8_BAR; PG8_WAIT_L(0); PG8_MMA(1, 0, At, B0); PG8_BAR; PG8_SCHED;
            PG8_STAGE(PG8_SB(0, 1), b2 + hstep, voffB);
            PG8_WAIT_V(6); PG8_BAR; PG8_MMA(1, 1, At, B1); PG8_BAR;
            PG8_LDB(B0, 1, 0); PG8_SCHED; PG8_LDA(At, 1, 0); PG8_STAGE(PG8_SA(0, 1), a2 + hstep, voffA);
            PG8_WAIT_L(8); PG8_BAR; PG8_WAIT_L(0); PG8_MMA(0, 0, At, B0); PG8_BAR; PG8_SCHED;
            PG8_LDB(B1, 1, 1); PG8_STAGE(PG8_SB(1, 0), b3, voffB);
            PG8_BAR; PG8_WAIT_L(0); PG8_MMA(0, 1, At, B1); PG8_BAR;
            PG8_LDA(At, 1, 1); PG8_STAGE(PG8_SA(1, 0), a3, voffA);
            PG8_BAR; PG8_WAIT_L(0); PG8_MMA(1, 0, At, B0); PG8_BAR; PG8_SCHED;
            PG8_STAGE(PG8_SB(1, 1), b3 + hstep, voffB);
            PG8_WAIT_V(6); PG8_BAR; PG8_MMA(1, 1, At, B1); PG8_BAR;
            }
        }
        if constexpr (ALIGN_EPI) { if (wr == 0) PG8_BAR; }
        E(acc, cur, wr, wc, fr, fq); S.done(cur);
        if (!has_next) break;
#pragma unroll
        for (int a = 0; a < 2; ++a)
#pragma unroll
            for (int b = 0; b < 2; ++b)
#pragma unroll
                for (int m = 0; m < 4; ++m)
#pragma unroll
                    for (int n = 0; n < 2; ++n) acc[a][b][m][n] = (f32x4){0.f, 0.f, 0.f, 0.f};
        cur = nxt; cA = nA; cB = nB; ++ui;
        if constexpr (ALIGN_EPI) { if (wr == 1) PG8_BAR; }
    }
    PG8_WAIT_V(0);
    if constexpr (!ALIGN_EPI) { if (wr == 0) PG8_BAR; }
    PG8_BAR;
#undef PG8_SA
#undef PG8_SB
#undef PG8_STAGE
#undef PG8_LDA
#undef PG8_LDB
#undef PG8_MMA
#undef PG8_WAIT_V
#undef PG8_WAIT_L
#undef PG8_BAR
#undef PG8_SCHED
}
}

struct Args {
    const float* x_prompt; const float* x_sample;
    const float* cache_k_cmp; const float* cache_v_cmp; const float* cache_k_slc; const float* cache_v_slc;
    const float* cache_k_win; const float* cache_v_win; const float* state_conv; const int* page_table;
    const float* c_prompt; const float* c_sample; const float* ada_w; const float* ada_b; const float* norm_g; const float* w_in;
    const float* cmp_pe_k; const float* cmp_w1_k; const float* cmp_w2_k; const float* cmp_pe_v; const float* cmp_w1_v; const float* cmp_w2_v;
    const float* conv_w; const float* w_out; const float* rel_bias; const float* final_g;
    float* out; unsigned char* ws; int ph_lo, ph_hi;
};
struct Frame {
    LAS unsigned char* lds; int tid, lane, wave, G, bid;
};

__host__ __device__ __forceinline__ int vslot32(int kk) { return kk < 16 ? 8 * (kk >> 2) + (kk & 3) : 8 * ((kk - 16) >> 2) + 4 + (kk & 3); }
__host__ __device__ __forceinline__ int inv_perm32(int lo) { return 16 * ((lo >> 2) & 1) + 4 * (lo >> 3) + (lo & 3); }

__device__ __forceinline__ void transpose_item(const float* W, int ldw, int src0, int nvalid, bf16_t* WT, int K, int dst0, bool perm, int k0, LAS float* scr, int lane) {
    const int c = lane & 31;
#pragma unroll 8
    for (int i = 0; i < 32; ++i) { const int kk = 2 * i + (lane >> 5); scr[kk * 33 + c] = (c < nvalid) ? W[(size_t)(k0 + kk) * ldw + src0 + c] : 0.f; }
    LDS_WAIT(); asm volatile("" ::: "memory");
    const int c8 = lane & 7;
#pragma unroll
    for (int j = 0; j < 4; ++j) { const int n = (lane >> 3) + 8 * j; const LAS float* s = scr + (8 * c8) * 33 + n;
        u32x4 o; o.x = pk_bf16(s[0 * 33], s[1 * 33]); o.y = pk_bf16(s[2 * 33], s[3 * 33]); o.z = pk_bf16(s[4 * 33], s[5 * 33]); o.w = pk_bf16(s[6 * 33], s[7 * 33]);
        const int dn = perm ? inv_perm32(n) : n;
        *(u32x4*)(WT + (size_t)(dst0 + dn) * K + k0 + 8 * c8) = o; }
    LDS_WAIT(); asm volatile("" ::: "memory");
}
__device__ __forceinline__ void win_group_src(int pg, int& src0, int& nvalid) {
    const int pn = pg >> 3, bj = (pg >> 2) & 1, wc = pg & 3; nvalid = 32;
    if (pn < 4) src0 = C_Q + 256 * pn + 128 * bj + 32 * wc;
    else if (pn < 8) src0 = C_ZA + 256 * (pn - 4) + 128 * bj + 32 * wc;
    else if (pn < 11) src0 = C_KV + 128 * (2 * (pn - 8) + bj) + 32 * wc;
    else if (pn == 11) { src0 = C_G + 32 * wc; nvalid = bj ? 0 : (wc == 0 ? 32 : (wc == 1 ? 16 : 0)); if (nvalid == 0) src0 = 0; }
    else if (pn < 20) src0 = (bj ? C_CC : C_HC) + 128 * (pn - 12) + 32 * wc;
    else src0 = (bj ? C_ZC : C_BC) + 128 * (pn - 20) + 32 * wc;
}

__device__ __forceinline__ void p0a(const Args& a, Frame& F) {
    unsigned char* ws = a.ws;
    {
        LAS float* scr = (LAS float*)(F.lds + F.wave * 8704);
        const int gw = F.bid * 8 + F.wave, NGW = F.G * 8;
        constexpr int I_IN = 224 * 16, I_OUT = 32 * 32, I_W1 = 4 * 64;
        constexpr int NITEMS = I_IN + I_OUT + 2 * I_W1;
        for (int it = gw; it < NITEMS; it += NGW) {
            int r = it;
            if (r < I_IN) { const int pg = r >> 4, kb = r & 15; int src0, nv; win_group_src(pg, src0, nv);
                transpose_item(a.w_in, DIN, src0, nv, (bf16_t*)(ws + WS_WINT), DM, pg * 32, true, kb * 64, scr, F.lane); continue; }
            r -= I_IN;
            if (r < I_OUT) { const int pg = r >> 5, kb = r & 31;
                transpose_item(a.w_out, DM, pg * 32, 32, (bf16_t*)(ws + WS_WOUTT), DMIX, pg * 32, true, kb * 64, scr, F.lane); continue; }
            r -= I_OUT;
            const int kv = r >= I_W1; if (kv) r -= I_W1;
            { const int pg = r >> 6, kb = r & 63;
              transpose_item(kv ? a.cmp_w1_v : a.cmp_w1_k, 128, pg * 32, 32, (bf16_t*)(ws + WS_W1T) + (size_t)kv * 128 * 4096, 4096, pg * 32, false, kb * 64, scr, F.lane); }
        }
    }
    __syncthreads();
    {
        LAS float* CS = (LAS float*)(F.lds) + F.wave * (18 * 128);
        LAS float* RED = (LAS float*)(F.lds + 73728);
        float* MOD = (float*)(ws + WS_MOD);
        for (int job = F.bid; job < 96; job += F.G) {
            const int cg = job >> 1, rh = job & 1, n = cg * 64 + F.lane, kb = F.wave * 128;
            for (int i = F.lane; i < 18 * 128; i += 64) { const int r = rh * 18 + i / 128, k = kb + (i & 127);
                CS[i] = (r < 4) ? a.c_prompt[r * DM + k] : a.c_sample[(r - 4) * DM + k]; }
            LDS_WAIT(); asm volatile("" ::: "memory");
            float acc[18];
#pragma unroll
            for (int r = 0; r < 18; ++r) acc[r] = 0.f;
            for (int k16 = 0; k16 < 128; k16 += 16) {
                float wv[16];
#pragma unroll
                for (int i = 0; i < 16; ++i) wv[i] = a.ada_w[(size_t)(kb + k16 + i) * 3072 + n];
#pragma unroll
                for (int q = 0; q < 4; ++q)
#pragma unroll
                    for (int r = 0; r < 18; ++r) { const f32x4 c4 = *(const LAS f32x4*)(CS + r * 128 + k16 + 4 * q); acc[r] += c4.x * wv[4 * q] + c4.y * wv[4 * q + 1] + c4.z * wv[4 * q + 2] + c4.w * wv[4 * q + 3]; }
            }
#pragma unroll
            for (int r = 0; r < 18; ++r) RED[(F.wave * 18 + r) * 64 + F.lane] = acc[r];
            __syncthreads();
            for (int o = F.tid; o < 18 * 64; o += 512) { const int r = o >> 6, l = o & 63; float s = 0.f;
#pragma unroll
                for (int w = 0; w < 8; ++w) s += RED[(w * 18 + r) * 64 + l];
                MOD[(rh * 18 + r) * 3072 + cg * 64 + l] = s + a.ada_b[cg * 64 + l]; }
            __syncthreads();
        }
    }
    if (F.bid == F.G - 3) {
        float* BT = (float*)(ws + WS_BT);
        for (int i = F.tid; i < 129 * 16; i += 512) { const int d = i >> 4, hh = i & 15; int bk;
            if (d < 16) bk = d; else { int lg = 16 + (int)(log((double)d / 16.0) / log(8.0) * 16.0); bk = lg < 31 ? lg : 31; }
            BT[i] = a.rel_bias[bk * 16 + hh] * LOG2E; }
    }
    {
        const size_t per = (size_t)508 * 128 / 4;
        const size_t total = 2 * DB * per;
        for (size_t i = (size_t)F.bid * 512 + F.tid; i < total; i += (size_t)F.G * 512) {
            const int t = (int)(i / (DB * per)); const size_t r = i % (DB * per); const int sb = (int)(r / per); const size_t o = r % per;
            const f32x4* src = (const f32x4*)((t ? a.cache_v_win : a.cache_k_win) + ((size_t)sb * 512 + 4) * 128) + o;
            f32x4* dst = (f32x4*)(a.out + O_SKW + (size_t)t * SZ_SW + (size_t)sb * 512 * 128) + o;
            *dst = *src;
        }
    }
}

__device__ __forceinline__ void p0b_rows(const Args& a, Frame& F) {
    const float* MOD = (const float*)(a.ws + WS_MOD); bf16_t* H = (bf16_t*)(a.ws + WS_H);
    const int gw = F.bid * 8 + F.wave, NGW = F.G * 8;
    for (int row = gw; row < MROWS; row += NGW) {
        unsigned long long* o8 = (unsigned long long*)(H + (size_t)row * DM) + F.lane;
        if (row >= NPR + NSR) {
#pragma unroll
            for (int j = 0; j < 4; ++j) o8[64 * j] = 0ull;
            continue; }
        const float* xr; int mr;
        if (row < NPR) { xr = a.x_prompt + (size_t)row * DM; mr = row >> 13; } else { xr = a.x_sample + (size_t)(row - NPR) * DM; mr = 4 + ((row - NPR) >> 2); }
        const f32x4* x4 = (const f32x4*)xr + F.lane;
        f32x4 v[4]; float s = 0.f;
#pragma unroll
        for (int j = 0; j < 4; ++j) { v[j] = x4[64 * j]; s += (v[j].x * v[j].x + v[j].y * v[j].y) + (v[j].z * v[j].z + v[j].w * v[j].w); }
        const float rstd = 1.f / sqrtf(wave_sum(s) * (1.f / DM) + EPS);
        const float* shift = MOD + (size_t)mr * 3072; const float* scale = shift + 1024;
#pragma unroll
        for (int j = 0; j < 4; ++j) { const int c = 4 * F.lane + 256 * j;
            const f32x4 g = *(const f32x4*)(a.norm_g + c), sc = *(const f32x4*)(scale + c), sh = *(const f32x4*)(shift + c);
            const f32x4 y = (v[j] * rstd * g) * (sc + 1.f) + sh;
            o8[64 * j] = (unsigned long long)pk_bf16(y.x, y.y) | ((unsigned long long)pk_bf16(y.z, y.w) << 32); }
    }
}

struct EpiIn {
    float* out; unsigned char* ws;
    __device__ __forceinline__ void operator()(const f32x4 (&acc)[2][2][4][2], const pg8::Unit& u, int wr, int wc, int fr, int fq) const {
        const int pn = u.pn, lc0 = wc * 32 + fq * 8;
#pragma unroll
        for (int ai = 0; ai < 2; ++ai)
#pragma unroll
            for (int m = 0; m < 4; ++m) {
                const int row = u.pm * 256 + ai * 128 + wr * 64 + m * 16 + fr;
                if (row >= NPR + NSR) continue;
                const f32x4 a0 = acc[ai][0][m][0], a1 = acc[ai][0][m][1], b0 = acc[ai][1][m][0], b1 = acc[ai][1][m][1];
                if (pn < 4) {
                    bf16_t* d = (bf16_t*)(ws + WS_Q) + (size_t)row * DM + 256 * pn + lc0;
                    u32x4 w0, w1;
                    w0.x = pk_bf16(a0.x * QSCALE, a0.y * QSCALE); w0.y = pk_bf16(a0.z * QSCALE, a0.w * QSCALE); w0.z = pk_bf16(a1.x * QSCALE, a1.y * QSCALE); w0.w = pk_bf16(a1.z * QSCALE, a1.w * QSCALE);
                    w1.x = pk_bf16(b0.x * QSCALE, b0.y * QSCALE); w1.y = pk_bf16(b0.z * QSCALE, b0.w * QSCALE); w1.z = pk_bf16(b1.x * QSCALE, b1.y * QSCALE); w1.w = pk_bf16(b1.z * QSCALE, b1.w * QSCALE);
                    *(u32x4*)d = w0; *(u32x4*)(d + 128) = w1;
                } else if (pn < 8) {
                    bf16_t* d = (bf16_t*)(ws + WS_SZA) + (size_t)row * DM + 256 * (pn - 4) + lc0;
                    u32x4 w0, w1;
                    w0.x = pk_bf16(siluf_(a0.x), siluf_(a0.y)); w0.y = pk_bf16(siluf_(a0.z), siluf_(a0.w)); w0.z = pk_bf16(siluf_(a1.x), siluf_(a1.y)); w0.w = pk_bf16(siluf_(a1.z), siluf_(a1.w));
                    w1.x = pk_bf16(siluf_(b0.x), siluf_(b0.y)); w1.y = pk_bf16(siluf_(b0.z), siluf_(b0.w)); w1.z = pk_bf16(siluf_(b1.x), siluf_(b1.y)); w1.w = pk_bf16(siluf_(b1.z), siluf_(b1.w));
                    *(u32x4*)d = w0; *(u32x4*)(d + 128) = w1;
                } else if (pn < 11) {
#pragma unroll
                    for (int bj = 0; bj < 2; ++bj) {
                        const int ti = 2 * (pn - 8) + bj; const f32x4 v0 = bj ? b0 : a0, v1 = bj ? b1 : a1;
                        float* fo = nullptr;
                        if (row < NPR) {
                            const int s = row & (SEQ - 1), b = row >> 13;
                            if (ti < 4) fo = out + O_PKC + (size_t)ti * SZ_PKV + (size_t)row * 128 + lc0;
                            else if (s >= SEQ - 512) fo = out + O_PKW + (size_t)(ti - 4) * SZ_PW + ((size_t)b * 512 + (s - (SEQ - 512))) * 128 + lc0;
                            if (ti == 0 || ti == 1 || ti == 2 || ti == 4) {
                                const size_t base = ti == 0 ? WS_KC : ti == 1 ? WS_VC : ti == 2 ? WS_KSL : WS_KW;
                                u32x4 w; w.x = pk_bf16(v0.x, v0.y); w.y = pk_bf16(v0.z, v0.w); w.z = pk_bf16(v1.x, v1.y); w.w = pk_bf16(v1.z, v1.w);
                                *(u32x4*)((bf16_t*)(ws + base) + (size_t)row * 128 + lc0) = w;
                            } else {
                                bf16_t* vt = (bf16_t*)(ws + (ti == 3 ? WS_VSLT : WS_VWT));
                                const int g = lc0 >> 6, d0 = lc0 & 63, blk = s >> 6, kk = s & 63, slot = (kk & 32) + vslot32(kk & 31);
                                bf16_t* p = vt + (((size_t)(b * 2 + g) * 128 + blk) * 64 + d0) * 64 + slot;
                                const unsigned w0 = pk_bf16(v0.x, v0.y), w1 = pk_bf16(v0.z, v0.w), w2 = pk_bf16(v1.x, v1.y), w3 = pk_bf16(v1.z, v1.w);
                                p[0] = (bf16_t)w0; p[64] = (bf16_t)(w0 >> 16); p[128] = (bf16_t)w1; p[192] = (bf16_t)(w1 >> 16);
                                p[256] = (bf16_t)w2; p[320] = (bf16_t)(w2 >> 16); p[384] = (bf16_t)w3; p[448] = (bf16_t)(w3 >> 16);
                            }
                        } else {
                            const int sr = row - NPR, sb = sr >> 2, t = sr & 3;
                            if (ti < 4) fo = out + O_SKC + (size_t)ti * SZ_SKV + (size_t)sr * 128 + lc0;
                            else fo = out + O_SKW + (size_t)(ti - 4) * SZ_SW + ((size_t)sb * 512 + 508 + t) * 128 + lc0;
                        }
                        if (fo) { *(f32x4*)fo = v0; *(f32x4*)(fo + 4) = v1; }
                    }
                } else if (pn == 11) {
                    if (lc0 < 48) { float* d = (float*)(ws + WS_G) + (size_t)row * 48 + lc0;
                        *(f32x4*)d = (f32x4){sigmoidf_(a0.x), sigmoidf_(a0.y), sigmoidf_(a0.z), sigmoidf_(a0.w)};
                        *(f32x4*)(d + 4) = (f32x4){sigmoidf_(a1.x), sigmoidf_(a1.y), sigmoidf_(a1.z), sigmoidf_(a1.w)}; }
                } else if (pn < 20) {
                    const int ch = 128 * (pn - 12) + lc0; const f32x4 u0 = a0 * b0, u1 = a1 * b1;
                    u32x4 w; w.x = pk_bf16(u0.x, u0.y); w.y = pk_bf16(u0.z, u0.w); w.z = pk_bf16(u1.x, u1.y); w.w = pk_bf16(u1.z, u1.w);
                    *(u32x4*)((bf16_t*)(ws + WS_U) + (size_t)row * DM + ch) = w;
                    float* fo = nullptr;
                    if (row < NPR) { const int s = row & (SEQ - 1); if (s >= SEQ - 2) fo = out + O_PCV + ((size_t)(row >> 13) * 2 + (s - (SEQ - 2))) * 1024 + ch; }
                    else { const int sr = row - NPR, t = sr & 3; if (t >= 2) fo = out + O_SCV + ((size_t)(sr >> 2) * 2 + (t - 2)) * 1024 + ch; }
                    if (fo) { *(f32x4*)fo = u0; *(f32x4*)(fo + 4) = u1; }
                } else {
                    const int ch = 128 * (pn - 20) + lc0;
                    u32x4 w; w.x = pk_bf16(a0.x * siluf_(b0.x), a0.y * siluf_(b0.y)); w.y = pk_bf16(a0.z * siluf_(b0.z), a0.w * siluf_(b0.w));
                    w.z = pk_bf16(a1.x * siluf_(b1.x), a1.y * siluf_(b1.y)); w.w = pk_bf16(a1.z * siluf_(b1.z), a1.w * siluf_(b1.w));
                    *(u32x4*)((bf16_t*)(ws + WS_BCZ) + (size_t)row * DM + ch) = w;
                }
            }
    }
};

struct EpiOut {
    float* out; unsigned char* ws; const float* x_prompt; const float* x_sample;
    __device__ __forceinline__ void operator()(const f32x4 (&acc)[2][2][4][2], const pg8::Unit& u, int wr, int wc, int fr, int fq) const {
        const int pn = u.pn, lc0 = wc * 32 + fq * 8; const float* MOD = (const float*)(ws + WS_MOD); float* RSQ = (float*)(ws + WS_RSQ);
#pragma unroll
        for (int ai = 0; ai < 2; ++ai)
#pragma unroll
            for (int m = 0; m < 4; ++m) {
                const int row = u.pm * 256 + ai * 128 + wr * 64 + m * 16 + fr;
                const bool valid = row < NPR + NSR; float ss = 0.f;
                if (valid) {
                    const float* xr; float* yr; int mr;
                    if (row < NPR) { xr = x_prompt + (size_t)row * DM; yr = out + O_YP + (size_t)row * DM; mr = row >> 13; }
                    else { xr = x_sample + (size_t)(row - NPR) * DM; yr = out + O_YS + (size_t)(row - NPR) * DM; mr = 4 + ((row - NPR) >> 2); }
                    const float* gate = MOD + (size_t)mr * 3072 + 2048;
#pragma unroll
                    for (int bj = 0; bj < 2; ++bj)
#pragma unroll
                        for (int n = 0; n < 2; ++n) { const int c = 256 * pn + 128 * bj + lc0 + 4 * n;
                            const f32x4 o = *(const f32x4*)(xr + c) + *(const f32x4*)(gate + c) * acc[ai][bj][m][n];
                            ss += (o.x * o.x + o.y * o.y) + (o.z * o.z + o.w * o.w);
                            *(f32x4*)(yr + c) = o; }
                }
                ss += __shfl_xor(ss, 16); ss += __shfl_xor(ss, 32);
                if (valid && fq == 0) RSQ[(size_t)row * 16 + pn * 4 + wc] = ss;
            }
    }
};

__device__ __forceinline__ void p5_rows(const Args& a, Frame& F) {
    const float* RSQ = (const float*)(a.ws + WS_RSQ);
    const int gw = F.bid * 8 + F.wave, NGW = F.G * 8;
    for (int row = gw; row < NPR + NSR; row += NGW) {
        float s = (F.lane < 16) ? RSQ[(size_t)row * 16 + F.lane] : 0.f;
        s = wave_sum(s);
        const float rstd = 1.f / sqrtf(s * (1.f / DM) + EPS);
        f32x4* y4 = (f32x4*)(row < NPR ? a.out + O_YP + (size_t)row * DM : a.out + O_YS + (size_t)(row - NPR) * DM) + F.lane;
#pragma unroll
        for (int j = 0; j < 4; ++j) { const f32x4 g = *((const f32x4*)a.final_g + F.lane + 64 * j); y4[64 * j] = y4[64 * j] * rstd * g; }
    }
}

__device__ __forceinline__ void conv_rows(const Args& a, Frame& F) {
    const bf16_t* U = (const bf16_t*)(a.ws + WS_U); const bf16_t* BCZ = (const bf16_t*)(a.ws + WS_BCZ); bf16_t* A2 = (bf16_t*)(a.ws + WS_A2);
    const size_t total = (size_t)(NPR + NSR) * 128;
    for (size_t i = (size_t)F.bid * 512 + F.tid; i < total; i += (size_t)F.G * 512) {
        const int row = (int)(i >> 7), c = (int)(i & 127) * 8;
        float um2[8], um1[8], u0[8], bz[8];
        { const u32x4 w = *(const u32x4*)(U + (size_t)row * DM + c); u0[0] = bflo(w.x); u0[1] = bfhi(w.x); u0[2] = bflo(w.y); u0[3] = bfhi(w.y); u0[4] = bflo(w.z); u0[5] = bfhi(w.z); u0[6] = bflo(w.w); u0[7] = bfhi(w.w); }
        { const u32x4 w = *(const u32x4*)(BCZ + (size_t)row * DM + c); bz[0] = bflo(w.x); bz[1] = bfhi(w.x); bz[2] = bflo(w.y); bz[3] = bfhi(w.y); bz[4] = bflo(w.z); bz[5] = bfhi(w.z); bz[6] = bflo(w.w); bz[7] = bfhi(w.w); }
        int t; const float* st = nullptr;
        if (row < NPR) t = row & (SEQ - 1); else { t = (row - NPR) & 3; st = a.state_conv + (size_t)((row - NPR) >> 2) * 2 * 1024 + c; }
        if (t >= 1) { const u32x4 w = *(const u32x4*)(U + (size_t)(row - 1) * DM + c); um1[0] = bflo(w.x); um1[1] = bfhi(w.x); um1[2] = bflo(w.y); um1[3] = bfhi(w.y); um1[4] = bflo(w.z); um1[5] = bfhi(w.z); um1[6] = bflo(w.w); um1[7] = bfhi(w.w); }
        else if (st) {
#pragma unroll
            for (int j = 0; j < 8; ++j) um1[j] = st[1024 + j]; }
        else {
#pragma unroll
            for (int j = 0; j < 8; ++j) um1[j] = 0.f; }
        if (t >= 2) { const u32x4 w = *(const u32x4*)(U + (size_t)(row - 2) * DM + c); um2[0] = bflo(w.x); um2[1] = bfhi(w.x); um2[2] = bflo(w.y); um2[3] = bfhi(w.y); um2[4] = bflo(w.z); um2[5] = bfhi(w.z); um2[6] = bflo(w.w); um2[7] = bfhi(w.w); }
        else if (st) {
#pragma unroll
            for (int j = 0; j < 8; ++j) um2[j] = st[(t == 1 ? 1024 : 0) + j]; }
        else {
#pragma unroll
            for (int j = 0; j < 8; ++j) um2[j] = 0.f; }
        float r[8];
#pragma unroll
        for (int j = 0; j < 8; ++j) r[j] = (a.conv_w[c + j] * um2[j] + a.conv_w[1024 + c + j] * um1[j] + a.conv_w[2048 + c + j] * u0[j]) * bz[j];
        u32x4 o; o.x = pk_bf16(r[0], r[1]); o.y = pk_bf16(r[2], r[3]); o.z = pk_bf16(r[4], r[5]); o.w = pk_bf16(r[6], r[7]);
        *(u32x4*)(A2 + (size_t)row * DMIX + 1024 + c) = o;
    }
}
__device__ __forceinline__ void a2_zero_pad(const Args& a, Frame& F) {
    bf16_t* A2 = (bf16_t*)(a.ws + WS_A2) + (size_t)(NPR + NSR) * DMIX;
    const size_t total = (size_t)(MROWS - NPR - NSR) * DMIX / 8;
    for (size_t i = (size_t)F.bid * 512 + F.tid; i < total; i += (size_t)F.G * 512) *(u32x4*)(A2 + i * 8) = (u32x4){0u, 0u, 0u, 0u};
}

template <int MODE> __device__ __forceinline__ void compress_unit(const Args& a, Frame& F, int kv, int tl) {
    LAS unsigned char* L = F.lds;
    constexpr int PITCH = 72, STG = 128 * PITCH * 2;
    const int tid = F.tid, lane = F.lane, w = F.wave, r16 = lane & 15, kq = lane >> 4;
    const int R = tid >> 2, c4 = tid & 3;
    const float* srcf = nullptr; const bf16_t* srcb = nullptr;
    if (MODE == 0) { const int sb = tl >> 2, blk = (tl & 3) * 64 + (R >> 1), g = R & 1; const int page = a.page_table[sb * 128 + (blk >> 1)];
        srcf = (kv ? a.cache_v_cmp : a.cache_k_cmp) + (((size_t)page * 128 + (blk & 1) * 64) * 2 + g) * 64 + c4 * 16; }
    else { const int GR = tl * 128 + R, bblk = GR >> 1, g = GR & 1, b = bblk >> 7, blk = bblk & 127;
        srcb = (const bf16_t*)(a.ws + (kv ? WS_VC : WS_KC)) + ((size_t)(b * SEQ + blk * 64)) * 128 + g * 64 + c4 * 16; }
    const bf16_t* wsrc = (const bf16_t*)(a.ws + WS_W1T) + (size_t)kv * 128 * 4096 + (size_t)R * 4096 + c4 * 16;
    const int wm = w >> 1, wn = w & 1;
    f32x4 acc[2][4];
#pragma unroll
    for (int i = 0; i < 2; ++i)
#pragma unroll
        for (int j = 0; j < 4; ++j) acc[i][j] = (f32x4){0.f, 0.f, 0.f, 0.f};
    u32x4 ra[2], rb[2];
    const float* pe = (kv ? a.cmp_pe_v : a.cmp_pe_k) + c4 * 16;
    auto load = [&](int ks) {
        const f32x4* pp = (const f32x4*)(pe + ks * 64); const f32x4 e0 = pp[0], e1 = pp[1], e2 = pp[2], e3 = pp[3];
        f32x4 v0, v1, v2, v3;
        if (MODE == 0) { const f32x4* p = (const f32x4*)(srcf + (size_t)ks * 128); v0 = p[0]; v1 = p[1]; v2 = p[2]; v3 = p[3]; }
        else { const u32x4* p = (const u32x4*)(srcb + (size_t)ks * 128); const u32x4 w0 = p[0], w1 = p[1];
            v0 = (f32x4){bflo(w0.x), bfhi(w0.x), bflo(w0.y), bfhi(w0.y)}; v1 = (f32x4){bflo(w0.z), bfhi(w0.z), bflo(w0.w), bfhi(w0.w)};
            v2 = (f32x4){bflo(w1.x), bfhi(w1.x), bflo(w1.y), bfhi(w1.y)}; v3 = (f32x4){bflo(w1.z), bfhi(w1.z), bflo(w1.w), bfhi(w1.w)}; }
        v0 = v0 + e0; v1 = v1 + e1; v2 = v2 + e2; v3 = v3 + e3;
        ra[0] = (u32x4){pk_bf16(v0.x, v0.y), pk_bf16(v0.z, v0.w), pk_bf16(v1.x, v1.y), pk_bf16(v1.z, v1.w)};
        ra[1] = (u32x4){pk_bf16(v2.x, v2.y), pk_bf16(v2.z, v2.w), pk_bf16(v3.x, v3.y), pk_bf16(v3.z, v3.w)};
        const u32x4* q = (const u32x4*)(wsrc + ks * 64); rb[0] = q[0]; rb[1] = q[1];
    };
    auto store = [&](int st) {
        LAS unsigned char* pa = L + st * STG + (R * PITCH + c4 * 16) * 2; LAS unsigned char* pb = L + 2 * STG + st * STG + (R * PITCH + c4 * 16) * 2;
        *(LAS u32x4*)pa = ra[0]; *(LAS u32x4*)(pa + 16) = ra[1]; *(LAS u32x4*)pb = rb[0]; *(LAS u32x4*)(pb + 16) = rb[1];
    };
    load(0); store(0); __syncthreads();
    for (int ks = 0; ks < 64; ++ks) {
        const int st = ks & 1;
        if (ks + 1 < 64) load(ks + 1);
        LAS const unsigned char* As = L + st * STG; LAS const unsigned char* Bs = L + 2 * STG + st * STG;
#pragma unroll
        for (int s = 0; s < 2; ++s) {
            bf16x8 af[2], bfr[4];
#pragma unroll
            for (int mi = 0; mi < 2; ++mi) af[mi] = *(const LAS bf16x8*)(As + ((32 * wm + 16 * mi + r16) * PITCH + 32 * s + 8 * kq) * 2);
#pragma unroll
            for (int ni = 0; ni < 4; ++ni) bfr[ni] = *(const LAS bf16x8*)(Bs + ((64 * wn + 16 * ni + r16) * PITCH + 32 * s + 8 * kq) * 2);
#pragma unroll
            for (int mi = 0; mi < 2; ++mi)
#pragma unroll
                for (int ni = 0; ni < 4; ++ni) acc[mi][ni] = __builtin_amdgcn_mfma_f32_16x16x32_bf16(af[mi], bfr[ni], acc[mi][ni], 0, 0, 0);
        }
        if (ks + 1 < 64) store(st ^ 1);
        __syncthreads();
    }
    LAS float* HID = (LAS float*)L; LAS float* W2s = (LAS float*)(L + 67584);
#pragma unroll
    for (int mi = 0; mi < 2; ++mi)
#pragma unroll
        for (int ni = 0; ni < 4; ++ni) { const int col = 64 * wn + 16 * ni + r16;
#pragma unroll
            for (int r = 0; r < 4; ++r) HID[(32 * wm + 16 * mi + 4 * kq + r) * 132 + col] = siluf_(acc[mi][ni][r]); }
    { const f32x4* w2 = (const f32x4*)(kv ? a.cmp_w2_v : a.cmp_w2_k);
#pragma unroll
      for (int i = 0; i < 4; ++i) ((LAS f32x4*)W2s)[tid + 512 * i] = w2[tid + 512 * i]; }
    __syncthreads();
    {
        float o[16];
#pragma unroll
        for (int j = 0; j < 16; ++j) o[j] = 0.f;
        for (int n = 0; n < 128; ++n) { const float h = HID[R * 132 + n]; const LAS f32x4* wr = (const LAS f32x4*)(W2s + n * 64 + c4 * 16);
#pragma unroll
            for (int q = 0; q < 4; ++q) { const f32x4 wv = wr[q]; o[4 * q] += h * wv.x; o[4 * q + 1] += h * wv.y; o[4 * q + 2] += h * wv.z; o[4 * q + 3] += h * wv.w; } }
        if (MODE == 0) { const int sb = tl >> 2, blk = (tl & 3) * 64 + (R >> 1), g = R & 1;
            float* d = (float*)(a.ws + (kv ? WS_VCMPS : WS_KCMPS)) + ((size_t)(sb * 2 + g) * 256 + blk) * 64 + c4 * 16;
#pragma unroll
            for (int q = 0; q < 4; ++q) *(f32x4*)(d + 4 * q) = (f32x4){o[4 * q], o[4 * q + 1], o[4 * q + 2], o[4 * q + 3]}; }
        else { const int GR = tl * 128 + R, bblk = GR >> 1, g = GR & 1, b = bblk >> 7, blk = bblk & 127;
            if (kv == 0) { bf16_t* d = (bf16_t*)(a.ws + WS_KCMPP) + ((size_t)(b * 2 + g) * 128 + blk) * 64 + c4 * 16;
                *(u32x4*)d = (u32x4){pk_bf16(o[0], o[1]), pk_bf16(o[2], o[3]), pk_bf16(o[4], o[5]), pk_bf16(o[6], o[7])};
                *(u32x4*)(d + 8) = (u32x4){pk_bf16(o[8], o[9]), pk_bf16(o[10], o[11]), pk_bf16(o[12], o[13]), pk_bf16(o[14], o[15])}; }
            else { bf16_t* d = (bf16_t*)(a.ws + WS_VCMPT) + ((size_t)(b * 2 + g) * 64 + c4 * 16) * 128 + (blk & ~31) + vslot32(blk & 31);
#pragma unroll
                for (int j = 0; j < 16; ++j) d[(size_t)j * 128] = (bf16_t)(pk_bf16(o[j], 0.f) & 0xffffu); } }
    }
    __syncthreads();
}

__device__ __forceinline__ int swz_off(int row, int chunk) { return row * 128 + ((chunk ^ (row & 7)) << 4); }
constexpr int NST = 4, STB = 16384;
__device__ __forceinline__ void tile_dma(const bf16_t* Kbg, const bf16_t* Vtbg, int j, LAS unsigned char* stage, int w, int lane) {
    const int c = w * 64 + lane, row = c >> 3, sc = (c & 7) ^ (row & 7);
    __builtin_amdgcn_global_load_lds((const unsigned*)(Kbg + (size_t)(64 * j + row) * 128 + sc * 8), (LAS unsigned*)(stage + w * 1024), 16, 0, 0);
    __builtin_amdgcn_global_load_lds((const unsigned*)(Vtbg + (size_t)j * 4096 + row * 64 + sc * 8), (LAS unsigned*)(stage + 8192 + w * 1024), 16, 0, 0);
}
__device__ __forceinline__ void tile_wait(int ahead) {
    if (ahead >= 2) asm volatile("s_waitcnt vmcnt(4)" ::: "memory"); else if (ahead == 1) asm volatile("s_waitcnt vmcnt(2)" ::: "memory"); else asm volatile("s_waitcnt vmcnt(0)" ::: "memory");
}
__device__ __forceinline__ void build_xt(const Args& a, Frame& F, int off, int DMAX, int NE, int DLIM, int g) {
    const float* BT = (const float*)(a.ws + WS_BT); LAS float* d = (LAS float*)(F.lds + off);
    for (int i = F.tid; i < NE * 8; i += 512) { const int dd = DMAX - (i >> 3); d[i] = (dd < 0 || dd > DLIM) ? NEG_INF : BT[(dd > 128 ? 128 : dd) * 16 + g * 8 + (i & 7)]; }
}
constexpr float LAZY_THR = 20.f;
template <int DMAX, bool COLSEL>
__device__ __forceinline__ void pair_tile(f32x4 (&O)[4], float& mrun, float& lrun, const bf16x8 (&Qf)[2], LAS const unsigned char* Kt, LAS const unsigned char* Vt,
                                          LAS const float* XT, int r16, int kq, bool colsel, int dbase, int hh) {
    const int dbc = dbase < DMAX ? dbase : DMAX;
    LAS const float* bp = XT + (4 * kq - dbc + DMAX) * 8 + (hh & 7);
    bf16x8 kf[4][2], vf[4][2]; f32x4 bs[4];
#pragma unroll
    for (int m = 0; m < 4; ++m)
#pragma unroll
        for (int s = 0; s < 2; ++s) kf[m][s] = *(const LAS bf16x8*)(Kt + swz_off(16 * m + r16, 4 * s + kq));
#pragma unroll
    for (int m = 0; m < 4; ++m)
#pragma unroll
        for (int r = 0; r < 4; ++r) bs[m][r] = bp[(16 * m + r) * 8];
    asm volatile("" ::: "memory");
    f32x4 S[4];
#pragma unroll
    for (int m = 0; m < 4; ++m) { S[m] = __builtin_amdgcn_mfma_f32_16x16x32_bf16(kf[m][0], Qf[0], (f32x4){0.f, 0.f, 0.f, 0.f}, 0, 0, 0); S[m] = __builtin_amdgcn_mfma_f32_16x16x32_bf16(kf[m][1], Qf[1], S[m], 0, 0, 0); }
#pragma unroll
    for (int md = 0; md < 4; ++md)
#pragma unroll
        for (int s = 0; s < 2; ++s) vf[md][s] = *(const LAS bf16x8*)(Vt + swz_off(16 * md + r16, 4 * s + kq));
    asm volatile("" ::: "memory");
    float mx4[4];
#pragma unroll
    for (int m = 0; m < 4; ++m) { S[m] = S[m] + bs[m];
        mx4[m] = fmaxf(fmaxf(S[m][0], S[m][1]), fmaxf(S[m][2], S[m][3])); }
    float mx = fmaxf(fmaxf(mx4[0], mx4[1]), fmaxf(mx4[2], mx4[3]));
    if (COLSEL && !colsel) mx = NEG_INF;
    if (__any(mx > mrun + LAZY_THR)) {
        mx = xmax_16_32(mx);
        const float mnew = fmaxf(mrun, mx), msafe = (mnew == NEG_INF) ? 0.f : mnew;
        const float alpha = fexp2(mrun - msafe);
        lrun *= alpha; mrun = mnew;
#pragma unroll
        for (int md = 0; md < 4; ++md) O[md] = O[md] * alpha;
    }
    const float mref = (COLSEL && !colsel) ? __builtin_inff() : ((mrun == NEG_INF) ? 0.f : mrun);
    float ps4[4];
#pragma unroll
    for (int m = 0; m < 4; ++m) {
#pragma unroll
        for (int r = 0; r < 4; ++r) S[m][r] = fexp2(S[m][r] - mref);
        ps4[m] = (S[m][0] + S[m][1]) + (S[m][2] + S[m][3]); }
    lrun += (ps4[0] + ps4[1]) + (ps4[2] + ps4[3]);
    bf16x8 Pf[2];
#pragma unroll
    for (int s = 0; s < 2; ++s) { const u32x4 w = (u32x4){pk_bf16(S[2 * s][0], S[2 * s][1]), pk_bf16(S[2 * s][2], S[2 * s][3]), pk_bf16(S[2 * s + 1][0], S[2 * s + 1][1]), pk_bf16(S[2 * s + 1][2], S[2 * s + 1][3])};
        Pf[s] = __builtin_bit_cast(bf16x8, w); }
#pragma unroll
    for (int md = 0; md < 4; ++md) { O[md] = __builtin_amdgcn_mfma_f32_16x16x32_bf16(vf[md][0], Pf[0], O[md], 0, 0, 0); O[md] = __builtin_amdgcn_mfma_f32_16x16x32_bf16(vf[md][1], Pf[1], O[md], 0, 0, 0); }
}

template <int DMAX>
__device__ __forceinline__ void quad_tile(f32x4 (&O)[4][4], float (&mrun)[4], float (&lrun)[4], LAS const bf16x8* QL, LAS const unsigned char* Kt, LAS const unsigned char* Vt,
                                          LAS const float* XT, int r16, int kq, int dbase0, int hh) {
    bf16x8 Pf[4][2];
    bf16x8 kf[4][2], vf[4][2];
    LAS const float* bp3 = XT + (4 * kq - dbase0 - 6 + DMAX) * 8 + (hh & 7);
#pragma unroll
    for (int m = 0; m < 4; ++m)
#pragma unroll
        for (int s = 0; s < 2; ++s) kf[m][s] = *(const LAS bf16x8*)(Kt + swz_off(16 * m + r16, 4 * s + kq));
    f32x4 bs[2][4]; bf16x8 qn[2][2];
#pragma unroll
    for (int m = 0; m < 4; ++m)
#pragma unroll
        for (int r = 0; r < 4; ++r) bs[0][m][r] = bp3[(16 * m + r + 6) * 8];
    qn[0][0] = QL[0]; qn[0][1] = QL[64];
    asm volatile("" ::: "memory");
#pragma unroll
    for (int p = 0; p < 4; ++p) {
        if (p < 3) {
#pragma unroll
            for (int m = 0; m < 4; ++m)
#pragma unroll
                for (int r = 0; r < 4; ++r) bs[(p + 1) & 1][m][r] = bp3[(16 * m + r + 6 - 2 * (p + 1)) * 8];
            qn[(p + 1) & 1][0] = QL[((p + 1) * 2) * 64]; qn[(p + 1) & 1][1] = QL[((p + 1) * 2 + 1) * 64];
        }
        asm volatile("" ::: "memory");
        f32x4 S[4];
#pragma unroll
        for (int m = 0; m < 4; ++m) { S[m] = __builtin_amdgcn_mfma_f32_16x16x32_bf16(kf[m][0], qn[p & 1][0], (f32x4){0.f, 0.f, 0.f, 0.f}, 0, 0, 0); S[m] = __builtin_amdgcn_mfma_f32_16x16x32_bf16(kf[m][1], qn[p & 1][1], S[m], 0, 0, 0); }
        float mx4[4];
#pragma unroll
        for (int m = 0; m < 4; ++m) { S[m] = S[m] + bs[p & 1][m]; mx4[m] = fmaxf(fmaxf(S[m][0], S[m][1]), fmaxf(S[m][2], S[m][3])); }
        float mx = fmaxf(fmaxf(mx4[0], mx4[1]), fmaxf(mx4[2], mx4[3]));
        if (__any(mx > mrun[p] + LAZY_THR)) {
            mx = xmax_16_32(mx);
            const float mnew = fmaxf(mrun[p], mx), msafe = (mnew == NEG_INF) ? 0.f : mnew;
            const float alpha = fexp2(mrun[p] - msafe);
            lrun[p] *= alpha; mrun[p] = mnew;
#pragma unroll
            for (int md = 0; md < 4; ++md) O[p][md] = O[p][md] * alpha;
        }
        const float mref = (mrun[p] == NEG_INF) ? 0.f : mrun[p];
        float ps4[4];
#pragma unroll
        for (int m = 0; m < 4; ++m) {
#pragma unroll
            for (int r = 0; r < 4; ++r) S[m][r] = fexp2(S[m][r] - mref);
            ps4[m] = (S[m][0] + S[m][1]) + (S[m][2] + S[m][3]); }
        lrun[p] += (ps4[0] + ps4[1]) + (ps4[2] + ps4[3]);
#pragma unroll
        for (int s = 0; s < 2; ++s) { const u32x4 w = (u32x4){pk_bf16(S[2 * s][0], S[2 * s][1]), pk_bf16(S[2 * s][2], S[2 * s][3]), pk_bf16(S[2 * s + 1][0], S[2 * s + 1][1]), pk_bf16(S[2 * s + 1][2], S[2 * s + 1][3])};
            Pf[p][s] = __builtin_bit_cast(bf16x8, w); }
    }
#pragma unroll
    for (int md = 0; md < 4; ++md)
#pragma unroll
        for (int s = 0; s < 2; ++s) vf[md][s] = *(const LAS bf16x8*)(Vt + swz_off(16 * md + r16, 4 * s + kq));
#pragma unroll
    for (int p = 0; p < 4; ++p)
#pragma unroll
        for (int md = 0; md < 4; ++md) { O[p][md] = __builtin_amdgcn_mfma_f32_16x16x32_bf16(vf[md][0], Pf[p][0], O[p][md], 0, 0, 0); O[p][md] = __builtin_amdgcn_mfma_f32_16x16x32_bf16(vf[md][1], Pf[p][1], O[p][md], 0, 0, 0); }
}

constexpr int AT_RING = 0;
constexpr int AT_KCMP = 65536;
constexpr int AT_VCMP = 81920;
constexpr int AT_SCORE = 98304;
constexpr int AT_XT = 131072;
constexpr int WIN_XT = 65536;
constexpr int WIN_QL = 65536 + 20480;
constexpr int SEL_DMAX = 255, SEL_NE = 319, WIN_DMAX = 575, WIN_NE = 639;
static_assert(AT_XT + SEL_NE * 32 <= LDS_CTL && WIN_XT + WIN_NE * 32 <= WIN_QL && WIN_QL + 65536 <= LDS_CTL, "attention LDS map");

__device__ __forceinline__ void win_unit(const Args& a, Frame& F, int b, int g, int qb) {
    LAS unsigned char* L = F.lds; const int lane = F.lane, w = F.wave, r16 = lane & 15, kq = lane >> 4, slot = r16 >> 3, h = r16 & 7, hh = g * 8 + h;
    const bf16_t* Kbg = (const bf16_t*)(a.ws + WS_KW) + (size_t)b * SEQ * 128 + g * 64;
    const bf16_t* Vtbg = (const bf16_t*)(a.ws + WS_VWT) + (size_t)(b * 2 + g) * 128 * 4096;
    const bf16_t* Qb = (const bf16_t*)(a.ws + WS_Q);
    LAS const float* XT = (LAS const float*)(L + WIN_XT);
    const int j0 = qb >= 8 ? qb - 8 : 0;
#pragma nounroll
    for (int t = 0; t < 3; ++t) if (j0 + t <= qb) tile_dma(Kbg, Vtbg, j0 + t, L + AT_RING + t * STB, w, lane);
    build_xt(a, F, WIN_XT, WIN_DMAX, WIN_NE, 512, g);
    LAS bf16x8* QL = (LAS bf16x8*)(L + WIN_QL + w * 8192) + lane;
#pragma unroll
    for (int p = 0; p < 4; ++p) { const int q = qb * 64 + w * 8 + 2 * p + slot; const bf16_t* qp = Qb + ((size_t)(b * SEQ + q)) * DM + g * 512 + h * 64 + 8 * kq;
        QL[(p * 2) * 64] = *(const bf16x8*)qp; QL[(p * 2 + 1) * 64] = *(const bf16x8*)(qp + 32); }
    f32x4 O[4][4]; float mr[4], lr[4];
#pragma unroll
    for (int p = 0; p < 4; ++p) { mr[p] = NEG_INF; lr[p] = 0.f;
#pragma unroll
        for (int md = 0; md < 4; ++md) O[p][md] = (f32x4){0.f, 0.f, 0.f, 0.f}; }
    asm volatile("s_waitcnt vmcnt(0) lgkmcnt(0)" ::: "memory");
    for (int j = j0; j <= qb; ++j) {
        tile_wait((qb - j) < 2 ? (qb - j) : 2);
        asm volatile("s_waitcnt lgkmcnt(0)" ::: "memory"); __builtin_amdgcn_s_barrier(); asm volatile("" ::: "memory");
        if (j + 3 <= qb) tile_dma(Kbg, Vtbg, j + 3, L + AT_RING + ((j - j0 + 3) % NST) * STB, w, lane);
        LAS const unsigned char* Kt = L + AT_RING + ((j - j0) % NST) * STB; LAS const unsigned char* Vt = Kt + 8192;
        quad_tile<WIN_DMAX>(O, mr, lr, QL, Kt, Vt, XT, r16, kq, 64 * (qb - j) + w * 8 + slot, hh);
    }
    bf16_t* OW = (bf16_t*)(a.ws + WS_OWIN);
#pragma unroll
    for (int p = 0; p < 4; ++p) { const float lt = xsum_16_32(lr[p]); const float inv = lt > 0.f ? 1.f / lt : 0.f;
        const int q = qb * 64 + w * 8 + 2 * p + slot; bf16_t* d = OW + ((size_t)(b * SEQ + q)) * DM + g * 512 + h * 64 + 4 * kq;
#pragma unroll
        for (int md = 0; md < 4; ++md) { const f32x4 o = O[p][md] * inv; *(u32x2*)(d + 16 * md) = (u32x2){pk_bf16(o.x, o.y), pk_bf16(o.z, o.w)}; } }
    __syncthreads();
}

template <int NE, int NQ> __device__ __forceinline__ void topk16(const unsigned (&key)[NQ][NE], unsigned long long (&sel)[NQ][NE], int lane) {
    unsigned T[NQ];
#pragma unroll
    for (int q = 0; q < NQ; ++q) T[q] = 0u;
    for (int bit = 31; bit >= 0; --bit) {
#pragma unroll
        for (int q = 0; q < NQ; ++q) { const unsigned cand = T[q] | (1u << bit); int cnt = 0;
#pragma unroll
            for (int e = 0; e < NE; ++e) cnt += __popcll(__ballot(key[q][e] >= cand));
            if (cnt >= 16) T[q] = cand; } }
    const unsigned long long lt = (1ull << lane) - 1ull;
#pragma unroll
    for (int q = 0; q < NQ; ++q) {
        if (T[q] == 0u) {
#pragma unroll
            for (int e = 0; e < NE; ++e) sel[q][e] = __ballot(key[q][e] > 0u);
        } else {
            int ngt = 0;
#pragma unroll
            for (int e = 0; e < NE; ++e) ngt += __popcll(__ballot(key[q][e] > T[q]));
            const int need = 16 - ngt; int prior = 0;
#pragma unroll
            for (int e = 0; e < NE; ++e) { const bool eq = key[q][e] == T[q]; const unsigned long long em = __ballot(eq); const int rank = prior + __popcll(em & lt);
                sel[q][e] = __ballot(key[q][e] > T[q] || (eq && rank < need)); prior += __popcll(em); }
        }
    }
}

__device__ __forceinline__ void nsa_unit(const Args& a, Frame& F, int b, int g, int qb) {
    LAS unsigned char* L = F.lds; const int tid = F.tid, lane = F.lane, w = F.wave, r16 = lane & 15, kq = lane >> 4, slot = r16 >> 3, h = r16 & 7, hh = g * 8 + h;
    const bf16_t* Kbg = (const bf16_t*)(a.ws + WS_KSL) + (size_t)b * SEQ * 128 + g * 64;
    const bf16_t* Vtbg = (const bf16_t*)(a.ws + WS_VSLT) + (size_t)(b * 2 + g) * 128 * 4096;
    const bf16_t* Qb = (const bf16_t*)(a.ws + WS_Q);
    LAS const float* XT = (LAS const float*)(L + AT_XT);
    LAS float* SCORE = (LAS float*)(L + AT_SCORE);
#pragma nounroll
    for (int t = 0; t < 3; ++t) if (t <= qb) tile_dma(Kbg, Vtbg, t, L + AT_RING + t * STB, w, lane);
    { const u32x4* ks = (const u32x4*)((const bf16_t*)(a.ws + WS_KCMPP) + (size_t)(b * 2 + g) * 128 * 64);
      const u32x4* vs = (const u32x4*)((const bf16_t*)(a.ws + WS_VCMPT) + (size_t)(b * 2 + g) * 64 * 128);
#pragma unroll
      for (int i = 0; i < 2; ++i) { const int c = tid + 512 * i;
          *(LAS u32x4*)(L + AT_KCMP + swz_off(c >> 3, c & 7)) = ks[c];
          const int row = c >> 4, ch = c & 15; *(LAS u32x4*)(L + AT_VCMP + row * 256 + (((ch & 8) | ((ch ^ row) & 7)) << 4)) = vs[c]; } }
    build_xt(a, F, AT_XT, SEL_DMAX, SEL_NE, 1 << 30, g);
    bf16x8 Qf[4][2];
#pragma unroll
    for (int p = 0; p < 4; ++p) { const int q = qb * 64 + w * 8 + 2 * p + slot; const bf16_t* qp = Qb + ((size_t)(b * SEQ + q)) * DM + g * 512 + h * 64 + 8 * kq;
        Qf[p][0] = *(const bf16x8*)qp; Qf[p][1] = *(const bf16x8*)(qp + 32); }
    __syncthreads();
    const float* Gt = (const float*)(a.ws + WS_G);
    bf16_t* A2 = (bf16_t*)(a.ws + WS_A2);
    const int nmt = (qb + 16) >> 4;
#pragma unroll
    for (int p = 0; p < 4; ++p) {
        const int i = w * 8 + 2 * p + slot, q = qb * 64 + i;
        f32x4 S[8]; float mx = NEG_INF;
#pragma unroll
        for (int m = 0; m < 8; ++m) { S[m] = (f32x4){NEG_INF, NEG_INF, NEG_INF, NEG_INF};
            if (m < nmt) { f32x4 c = (f32x4){0.f, 0.f, 0.f, 0.f};
#pragma unroll
                for (int s = 0; s < 2; ++s) { const bf16x8 kf = *(const LAS bf16x8*)(L + AT_KCMP + swz_off(16 * m + r16, 4 * s + kq)); c = __builtin_amdgcn_mfma_f32_16x16x32_bf16(kf, Qf[p][s], c, 0, 0, 0); }
#pragma unroll
                for (int r = 0; r < 4; ++r) { const int jb = 16 * m + 4 * kq + r; const bool vis = (jb < qb) || (jb == qb && i == 63);
                    int d = 64 * (qb - jb) + i - 63; d = d < 0 ? 0 : (d > 128 ? 128 : d);
                    const float v = vis ? c[r] + XT[(SEL_DMAX - d) * 8 + h] : NEG_INF; S[m][r] = v; mx = fmaxf(mx, v); } } }
        mx = xmax_16_32(mx);
        const float msafe = (mx == NEG_INF) ? 0.f : mx; float ps = 0.f;
#pragma unroll
        for (int m = 0; m < 8; ++m)
#pragma unroll
            for (int r = 0; r < 4; ++r) { const float pp = fexp2(S[m][r] - msafe); S[m][r] = pp; ps += pp; }
        ps = xsum_16_32(ps);
        const float inv = ps > 0.f ? 1.f / ps : 0.f;
#pragma unroll
        for (int m = 0; m < 8; ++m) { f32x4 pn = S[m] * inv; S[m] = pn;
            f32x4 im = pn;
#pragma unroll
            for (int r = 0; r < 4; ++r) im[r] = dpp_sum8(im[r]);
#pragma unroll
            for (int r = 0; r < 4; ++r) { const int jb = 16 * m + 4 * kq + r; const bool vis = (jb < qb) || (jb == qb && i == 63);
                im[r] = vis ? im[r] : (jb <= qb ? 2.0f : -1.0f); }
            if (h == 0) *(LAS f32x4*)(SCORE + i * 128 + 16 * m + 4 * kq) = im; }
        f32x4 oc[4];
#pragma unroll
        for (int md = 0; md < 4; ++md) oc[md] = (f32x4){0.f, 0.f, 0.f, 0.f};
#pragma unroll
        for (int s = 0; s < 4; ++s) if (2 * s < nmt) {
            const u32x4 wv = (u32x4){pk_bf16(S[2 * s][0], S[2 * s][1]), pk_bf16(S[2 * s][2], S[2 * s][3]), pk_bf16(S[2 * s + 1][0], S[2 * s + 1][1]), pk_bf16(S[2 * s + 1][2], S[2 * s + 1][3])};
            const bf16x8 pf = __builtin_bit_cast(bf16x8, wv);
#pragma unroll
            for (int md = 0; md < 4; ++md) { const int row = 16 * md + r16, ch = 4 * s + kq;
                const bf16x8 vf = *(const LAS bf16x8*)(L + AT_VCMP + row * 256 + (((ch & 8) | ((ch ^ row) & 7)) << 4));
                oc[md] = __builtin_amdgcn_mfma_f32_16x16x32_bf16(vf, pf, oc[md], 0, 0, 0); } }
        const float g0 = Gt[(size_t)(b * SEQ + q) * 48 + hh];
#pragma unroll
        for (int md = 0; md < 4; ++md) { const f32x4 o = oc[md] * g0;
            *(u32x2*)(A2 + (size_t)(b * SEQ + q) * DMIX + g * 512 + h * 64 + 4 * kq + 16 * md) = (u32x2){pk_bf16(o.x, o.y), pk_bf16(o.z, o.w)}; }
    }
    LDS_WAIT(); __builtin_amdgcn_wave_barrier(); asm volatile("" ::: "memory");
    unsigned long long mA[8], mB[8];
#pragma unroll
    for (int qh = 0; qh < 2; ++qh) { unsigned key[4][2]; unsigned long long sel[4][2];
#pragma unroll
        for (int qq = 0; qq < 4; ++qq) { const int i = w * 8 + 4 * qh + qq; const float sa = SCORE[i * 128 + lane], sb = SCORE[i * 128 + 64 + lane];
            key[qq][0] = sa >= 0.f ? __float_as_uint(sa) + 1u : 0u; key[qq][1] = sb >= 0.f ? __float_as_uint(sb) + 1u : 0u; }
        topk16<2, 4>(key, sel, lane);
#pragma unroll
        for (int qq = 0; qq < 4; ++qq) { mA[4 * qh + qq] = sel[qq][0]; mB[4 * qh + qq] = sel[qq][1]; } }
    __syncthreads();
    LAS bf16x8* QL = (LAS bf16x8*)(L + AT_KCMP + w * 8192) + lane;
#pragma unroll
    for (int p = 0; p < 4; ++p) { QL[(p * 2) * 64] = Qf[p][0]; QL[(p * 2 + 1) * 64] = Qf[p][1]; }
    LDS_WAIT(); asm volatile("" ::: "memory");
    f32x4 O[4][4]; float mr[4], lr[4];
#pragma unroll
    for (int p = 0; p < 4; ++p) { mr[p] = NEG_INF; lr[p] = 0.f;
#pragma unroll
        for (int md = 0; md < 4; ++md) O[p][md] = (f32x4){0.f, 0.f, 0.f, 0.f}; }
    asm volatile("s_waitcnt vmcnt(0)" ::: "memory");
    for (int j = 0; j <= qb; ++j) {
        if (j >= 3) tile_wait((qb - j) < 2 ? (qb - j) : 2);
        asm volatile("s_waitcnt lgkmcnt(0)" ::: "memory"); __builtin_amdgcn_s_barrier(); asm volatile("" ::: "memory");
        if (j + 3 <= qb) tile_dma(Kbg, Vtbg, j + 3, L + AT_RING + ((j + 3) % NST) * STB, w, lane);
        LAS const unsigned char* Kt = L + AT_RING + (j % NST) * STB; LAS const unsigned char* Vt = Kt + 8192;
#pragma unroll
        for (int p = 0; p < 4; ++p) {
            const bool a0 = (((j < 64 ? mA[2 * p] : mB[2 * p]) >> (j & 63)) & 1ull) != 0ull, a1 = (((j < 64 ? mA[2 * p + 1] : mB[2 * p + 1]) >> (j & 63)) & 1ull) != 0ull;
            if (a0 || a1) { const int i = w * 8 + 2 * p + slot; bf16x8 qf[2]; qf[0] = QL[(p * 2) * 64]; qf[1] = QL[(p * 2 + 1) * 64];
                pair_tile<SEL_DMAX, true>(O[p], mr[p], lr[p], qf, Kt, Vt, XT, r16, kq, slot ? a1 : a0, 64 * (qb - j) + i, hh); } }
    }
    const bf16_t* OW = (const bf16_t*)(a.ws + WS_OWIN); const bf16_t* SZ = (const bf16_t*)(a.ws + WS_SZA);
#pragma unroll
    for (int p = 0; p < 4; ++p) { const float lt = xsum_16_32(lr[p]);
        const int q = qb * 64 + w * 8 + 2 * p + slot; const size_t row = (size_t)(b * SEQ + q);
        const float g1 = Gt[row * 48 + 16 + hh], g2 = Gt[row * 48 + 32 + hh]; const float inv = lt > 0.f ? g1 / lt : 0.f;
        const int col = g * 512 + h * 64 + 4 * kq;
#pragma unroll
        for (int md = 0; md < 4; ++md) { const u32x2 ow = *(const u32x2*)(OW + row * DM + col + 16 * md), sz = *(const u32x2*)(SZ + row * DM + col + 16 * md);
            const u32x2 ocv = __builtin_nontemporal_load((const u32x2*)(A2 + row * DMIX + col + 16 * md));
            const f32x4 o = (f32x4){bflo(ocv.x), bfhi(ocv.x), bflo(ocv.y), bfhi(ocv.y)} + O[p][md] * inv + (f32x4){bflo(ow.x), bfhi(ow.x), bflo(ow.y), bfhi(ow.y)} * g2;
            const f32x4 r = o * (f32x4){bflo(sz.x), bfhi(sz.x), bflo(sz.y), bfhi(sz.y)};
            *(u32x2*)(A2 + row * DMIX + col + 16 * md) = (u32x2){pk_bf16(r.x, r.y), pk_bf16(r.z, r.w)}; }
        asm volatile("" ::: "memory"); }
    __syncthreads();
}

constexpr int SU_KT = 0, SU_VT = 17408, SU_QS = 34816, SU_PW = 36864, SU_IMP = 38912, SU_BT = 47360, SU_SEL = 55616, SU_SCORE = 55808;
struct VSrc { const float* k; const float* v; bool ok; };
__device__ __forceinline__ float valu_tile(LAS const float* KT, LAS const float* VT, LAS const float* QSh, LAS float* PWh, int lane, bool ok, float bias, float& m, float& l, float& O) {
    float s = 0.f;
#pragma unroll 4
    for (int d4 = 0; d4 < 16; ++d4) { const f32x4 kk = *(const LAS f32x4*)(KT + lane * 68 + 4 * d4), qq = *(const LAS f32x4*)(QSh + 4 * d4); s += kk.x * qq.x + kk.y * qq.y + kk.z * qq.z + kk.w * qq.w; }
    s = ok ? s + bias : NEG_INF;
    const float mt = wave_max(s), mnew = fmaxf(m, mt), msafe = (mnew == NEG_INF) ? 0.f : mnew;
    const float alpha = fexp2(m - msafe), p = fexp2(s - msafe);
    l = l * alpha + wave_sum(p); m = mnew;
    PWh[lane] = p; LDS_WAIT(); __builtin_amdgcn_wave_barrier();
    float o = O * alpha;
#pragma unroll 4
    for (int k4 = 0; k4 < 16; ++k4) { const f32x4 pp = *(const LAS f32x4*)(PWh + 4 * k4);
        o += pp.x * VT[(4 * k4) * 68 + lane] + pp.y * VT[(4 * k4 + 1) * 68 + lane] + pp.z * VT[(4 * k4 + 2) * 68 + lane] + pp.w * VT[(4 * k4 + 3) * 68 + lane]; }
    O = o; LDS_WAIT(); __builtin_amdgcn_wave_barrier();
    return s;
}
struct VRegs { f32x4 k0, k1, v0, v1; };
__device__ __forceinline__ void vfetch(VRegs& r, const VSrc& s) {
    if (s.ok) { const f32x4* kp = (const f32x4*)s.k; const f32x4* vp = (const f32x4*)s.v; r.k0 = kp[0]; r.k1 = kp[1]; r.v0 = vp[0]; r.v1 = vp[1]; }
    else { r.k0 = r.k1 = r.v0 = r.v1 = (f32x4){0.f, 0.f, 0.f, 0.f}; }
}
__device__ __forceinline__ void vstore(const VRegs& r, LAS unsigned char* L, int tid) {
    LAS float* kd = (LAS float*)(L + SU_KT) + (tid >> 3) * 68 + (tid & 7) * 8; LAS float* vd = (LAS float*)(L + SU_VT) + (tid >> 3) * 68 + (tid & 7) * 8;
    *(LAS f32x4*)kd = r.k0; *(LAS f32x4*)(kd + 4) = r.k1; *(LAS f32x4*)vd = r.v0; *(LAS f32x4*)(vd + 4) = r.v1;
}
__device__ __forceinline__ void load_bt(const Args& a, Frame& F, int off) {
    const float* BT = (const float*)(a.ws + WS_BT); LAS float* d = (LAS float*)(F.lds + off);
    for (int i = F.tid; i < 129 * 16; i += 512) d[i] = BT[i];
}
__device__ __forceinline__ void sample_unit(const Args& a, Frame& F, int sb, int g, int t) {
    LAS unsigned char* L = F.lds; const int tid = F.tid, lane = F.lane, h = F.wave, hh = g * 8 + h, key = tid >> 3, c8 = tid & 7;
    const int qpos = PAST + t; const size_t row = (size_t)NPR + sb * 4 + t;
    LAS float* QSh = (LAS float*)(L + SU_QS) + h * 64; LAS float* PWh = (LAS float*)(L + SU_PW) + h * 64; LAS float* IMP = (LAS float*)(L + SU_IMP);
    LAS const float* BTl = (LAS const float*)(L + SU_BT); LAS int* SEL = (LAS int*)(L + SU_SEL); LAS float* SCORE = (LAS float*)(L + SU_SCORE);
    LAS const float* KT = (LAS const float*)(L + SU_KT); LAS const float* VT = (LAS const float*)(L + SU_VT);
    load_bt(a, F, SU_BT);
    QSh[lane] = bf2f(((const bf16_t*)(a.ws + WS_Q))[row * DM + g * 512 + h * 64 + lane]);
    VRegs vr; VSrc src;
    const float* kc = (const float*)(a.ws + WS_KCMPS) + (size_t)(sb * 2 + g) * 256 * 64; const float* vc = (const float*)(a.ws + WS_VCMPS) + (size_t)(sb * 2 + g) * 256 * 64;
    float mc = NEG_INF, lc = 0.f, oc = 0.f, sc[4];
    src.k = kc + (size_t)key * 64 + c8 * 8; src.v = vc + (size_t)key * 64 + c8 * 8; src.ok = true; vfetch(vr, src);
    __syncthreads();
#pragma unroll
    for (int tl = 0; tl < 4; ++tl) {
        vstore(vr, L, tid); __syncthreads();
        if (tl < 3) { src.k = kc + (size_t)(64 * (tl + 1) + key) * 64 + c8 * 8; src.v = vc + (size_t)(64 * (tl + 1) + key) * 64 + c8 * 8; vfetch(vr, src); }
        int d = qpos - (64 * (64 * tl + lane) + 63); d = d > 128 ? 128 : d;
        sc[tl] = valu_tile(KT, VT, QSh, PWh, lane, true, BTl[d * 16 + hh], mc, lc, oc);
        __syncthreads();
    }
    { const float inv = 1.f / lc;
#pragma unroll
      for (int tl = 0; tl < 4; ++tl) IMP[h * 264 + 64 * tl + lane] = fexp2(sc[tl] - mc) * inv;
      oc *= inv; }
    __syncthreads();
    if (tid < 256) { float s = 0.f;
#pragma unroll
        for (int hq = 0; hq < 8; ++hq) s += IMP[hq * 264 + tid]; SCORE[tid] = s; }
    if (tid == 256) SCORE[256] = 2.0f;
    __syncthreads();
    if (h == 0) {
        unsigned keyv[1][5];
#pragma unroll
        for (int e = 0; e < 4; ++e) { const float s = SCORE[64 * e + lane]; keyv[0][e] = s >= 0.f ? __float_as_uint(s) + 1u : 0u; }
        keyv[0][4] = (lane == 0) ? __float_as_uint(SCORE[256]) + 1u : 0u;
        unsigned long long sel[1][5]; topk16<5, 1>(keyv, sel, lane);
        int base = 0;
#pragma unroll
        for (int e = 0; e < 5; ++e) { const bool on = (sel[0][e] >> lane) & 1ull; const int pos = base + __popcll(sel[0][e] & ((1ull << lane) - 1ull)); if (on && pos < 16) SEL[pos] = 64 * e + lane; base += __popcll(sel[0][e]); }
        if (lane == 0) SEL[16] = base < 16 ? base : 16;
    }
    __syncthreads();
    const int nsel = SEL[16];
    float ms = NEG_INF, ls = 0.f, os = 0.f;
    auto sel_src = [&](int n) { const int idx = SEL[n]; VSrc s;
        if (idx < 256) { const int page = a.page_table[sb * 128 + (idx >> 1)]; const size_t off = (((size_t)page * 128 + (idx & 1) * 64 + key) * 2 + g) * 64 + c8 * 8; s.k = a.cache_k_slc + off; s.v = a.cache_v_slc + off; s.ok = true; }
        else { const size_t off = ((size_t)(sb * 4 + (key & 3)) * 2 + g) * 64 + c8 * 8; s.k = a.out + O_SKC + 2 * SZ_SKV + off; s.v = a.out + O_SKC + 3 * SZ_SKV + off; s.ok = key < 4; }
        return s; };
    if (nsel > 0) { src = sel_src(0); vfetch(vr, src); }
    for (int n = 0; n < nsel; ++n) {
        vstore(vr, L, tid); __syncthreads();
        const int idx = SEL[n];
        if (n + 1 < nsel) { src = sel_src(n + 1); vfetch(vr, src); }
        int d = qpos - (64 * idx + lane); const bool ok = d >= 0; d = d < 0 ? 0 : (d > 128 ? 128 : d);
        (void)valu_tile(KT, VT, QSh, PWh, lane, ok, BTl[d * 16 + hh], ms, ls, os);
        __syncthreads();
    }
    float mw = NEG_INF, lw = 0.f, ow = 0.f;
    auto win_src = [&](int n) { VSrc s;
        if (n < 8) { const size_t off = (((size_t)sb * 512 + 64 * n + key) * 2 + g) * 64 + c8 * 8; s.k = a.cache_k_win + off; s.v = a.cache_v_win + off; s.ok = true; }
        else { const size_t off = (((size_t)sb * 512 + 508 + (key & 3)) * 2 + g) * 64 + c8 * 8; s.k = a.out + O_SKW + off; s.v = a.out + O_SKW + SZ_SW + off; s.ok = key < 4; }
        return s; };
    src = win_src(0); vfetch(vr, src);
    for (int n = 0; n < 9; ++n) {
        vstore(vr, L, tid); __syncthreads();
        if (n + 1 < 9) { src = win_src(n + 1); vfetch(vr, src); }
        int d; bool ok;
        if (n < 8) { const int r = 64 * n + lane; d = 512 + t - r; ok = r >= t; } else { d = t - lane; ok = lane <= t; }
        d = d < 0 ? 0 : (d > 128 ? 128 : d);
        (void)valu_tile(KT, VT, QSh, PWh, lane, ok, BTl[d * 16 + hh], mw, lw, ow);
        __syncthreads();
    }
    const float* Gt = (const float*)(a.ws + WS_G) + row * 48;
    const float o = Gt[hh] * oc + Gt[16 + hh] * (ls > 0.f ? os / ls : 0.f) + Gt[32 + hh] * (lw > 0.f ? ow / lw : 0.f);
    const int col = g * 512 + h * 64 + lane;
    const float sz = bf2f(((const bf16_t*)(a.ws + WS_SZA))[row * DM + col]);
    ((bf16_t*)(a.ws + WS_A2))[row * DMIX + col] = (bf16_t)(pk_bf16(o * sz, 0.f) & 0xffffu);
    __syncthreads();
}

constexpr int NPHASE = 7;
__global__ void __launch_bounds__(512, 2) fwd(Args a) {
    extern __shared__ __attribute__((aligned(16))) unsigned char lds_raw[];
    Frame F; F.lds = (LAS unsigned char*)lds_raw; F.tid = threadIdx.x; F.lane = F.tid & 63; F.wave = __builtin_amdgcn_readfirstlane(F.tid >> 6); F.G = gridDim.x; F.bid = blockIdx.x;
    for (int u = F.tid; u < (LDS_BYTES - LDS_CTL) / 4; u += 512) ((LAS unsigned*)(F.lds + LDS_CTL))[u] = 0u;
    __syncthreads();
    unsigned* ctl = (unsigned*)(a.ws + WS_CTL);
    XcdBarrier bar = xcd_barrier_post(ctl + 4096, (volatile LAS unsigned*)(F.lds + LDS_CTL));
    const int lo = a.ph_lo, hi = a.ph_hi;
#define IN(k) (lo <= (k) && (k) < hi)
#define SEAM(k) do { if (IN(k) && IN((k) + 1)) xcd_barrier(bar); } while (0)
    const int vcu = (F.G % 8 == 0) ? (F.bid % 8) * (F.G / 8) + F.bid / 8 : F.bid;
    if (IN(0)) { p0a(a, F); }
    SEAM(0);
    if (IN(1)) {
        p0b_rows(a, F);
        for (int u = F.bid; u < 256; u += F.G) compress_unit<0>(a, F, u >> 7, u & 127);
    }
    SEAM(1);
    if (IN(2)) {
        pg8::Gemm g{(const bf16_t*)(a.ws + WS_H), (const bf16_t*)(a.ws + WS_WINT), MROWS, NIN_PAD, DM};
        pg8::StaticOrder S; S.init(MROWS, NIN_PAD, F.G, F.bid);
        EpiIn E{a.out, a.ws};
        pg8::gemm_phase<EpiIn, pg8::StaticOrder, true, true>(F.lds, g, S, E);
    }
    SEAM(2);
    if (IN(3)) {
        for (int u = F.bid; u < 16; u += F.G) compress_unit<1>(a, F, u >> 3, u & 7);
        for (int u = vcu; u < 256; u += F.G) sample_unit(a, F, u >> 3, (u >> 2) & 1, u & 3);
        for (int u = vcu; u < 1024; u += F.G) { const int v = u & 255, k = u >> 8, s = v & 31; const int qb = k == 0 ? s : (k == 1 ? 63 - s : (k == 2 ? 64 + s : 127 - s));
            win_unit(a, F, v >> 6, (v >> 5) & 1, qb); }
        conv_rows(a, F); a2_zero_pad(a, F);
    }
    SEAM(3);
    if (IN(4)) {
        for (int u = vcu; u < 1024; u += F.G) { const int v = u & 255, k = u >> 8, s = v & 31; const int qb = k == 0 ? s : (k == 1 ? 63 - s : (k == 2 ? 64 + s : 127 - s));
            nsa_unit(a, F, v >> 6, (v >> 5) & 1, qb); }
    }
    SEAM(4);
    if (IN(5)) {
        pg8::Gemm g{(const bf16_t*)(a.ws + WS_A2), (const bf16_t*)(a.ws + WS_WOUTT), MROWS, DM, DMIX};
        pg8::StaticOrder S; S.init(MROWS, DM, F.G, F.bid);
        EpiOut E{a.out, a.ws, a.x_prompt, a.x_sample};
        pg8::gemm_phase<EpiOut, pg8::StaticOrder, true, true>(F.lds, g, S, E);
    }
    SEAM(5);
    if (IN(6)) { p5_rows(a, F); }
#undef IN
#undef SEAM
}

#ifndef MK_PER_PHASE
#define MK_PER_PHASE 0
#endif
extern "C" void kernel_launch(void* const* d_in, const int* in_sizes, int n_in, void* d_out, int out_size, void* d_ws, size_t ws_size, hipStream_t stream) {
    static int grid = 0;
    if (grid == 0) {
        if (n_in != 26 || (size_t)out_size != O_END || ws_size < WS_END) { fprintf(stderr, "kernel_launch: unexpected shapes: n_in %d out %d ws %zu\n", n_in, out_size, ws_size); grid = -1; return; }
        int dev = 0, cus = 0, per_cu = 0;
        if (hipGetDevice(&dev) != hipSuccess || hipDeviceGetAttribute(&cus, hipDeviceAttributeMultiprocessorCount, dev) != hipSuccess) { grid = -1; return; }
        if (hipFuncSetAttribute((const void*)fwd, hipFuncAttributeMaxDynamicSharedMemorySize, LDS_BYTES) != hipSuccess) { fprintf(stderr, "kernel_launch: hipFuncSetAttribute failed\n"); grid = -1; return; }
        if (hipOccupancyMaxActiveBlocksPerMultiprocessor(&per_cu, (const void*)fwd, 512, LDS_BYTES) != hipSuccess || per_cu < 1) { fprintf(stderr, "kernel_launch: occupancy query says %d\n", per_cu); }
        (void)hipGetLastError();
        grid = cus;
    }
    if (grid < 0) return;
    (void)hipMemsetAsync((char*)d_ws + WS_CTL, 0, CTL_ZERO_BYTES, stream);
    Args a{};
    a.x_prompt = (const float*)d_in[0]; a.x_sample = (const float*)d_in[1];
    a.cache_k_cmp = (const float*)d_in[2]; a.cache_v_cmp = (const float*)d_in[3]; a.cache_k_slc = (const float*)d_in[4]; a.cache_v_slc = (const float*)d_in[5];
    a.cache_k_win = (const float*)d_in[6]; a.cache_v_win = (const float*)d_in[7]; a.state_conv = (const float*)d_in[8]; a.page_table = (const int*)d_in[9];
    a.c_prompt = (const float*)d_in[10]; a.c_sample = (const float*)d_in[11]; a.ada_w = (const float*)d_in[12]; a.ada_b = (const float*)d_in[13]; a.norm_g = (const float*)d_in[14]; a.w_in = (const float*)d_in[15];
    a.cmp_pe_k = (const float*)d_in[16]; a.cmp_w1_k = (const float*)d_in[17]; a.cmp_w2_k = (const float*)d_in[18]; a.cmp_pe_v = (const float*)d_in[19]; a.cmp_w1_v = (const float*)d_in[20]; a.cmp_w2_v = (const float*)d_in[21];
    a.conv_w = (const float*)d_in[22]; a.w_out = (const float*)d_in[23]; a.rel_bias = (const float*)d_in[24]; a.final_g = (const float*)d_in[25];
    a.out = (float*)d_out; a.ws = (unsigned char*)d_ws;
#if MK_PER_PHASE
    for (int p = 0; p < NPHASE; ++p) { a.ph_lo = p; a.ph_hi = p + 1; hipLaunchKernelGGL(fwd, dim3(grid), dim3(512), LDS_BYTES, stream, a); }
#else
    a.ph_lo = 0; a.ph_hi = NPHASE;
    hipLaunchKernelGGL(fwd, dim3(grid), dim3(512), LDS_BYTES, stream, a);
#endif
#ifdef PROBE_REPEAT_PHASE
    a.ph_lo = PROBE_REPEAT_PHASE; a.ph_hi = PROBE_REPEAT_PHASE + 1;
    hipLaunchKernelGGL(fwd, dim3(grid), dim3(512), LDS_BYTES, stream, a);
#endif
    const hipError_t le = hipPeekAtLastError();
    if (le != hipSuccess) fprintf(stderr, "kernel_launch: launch failed: %s\n", hipGetErrorName(le));
}
```

```cpp
#include <hip/hip_runtime.h>
#include <cstdio>
#include <cstdint>

#define LAS __attribute__((address_space(3)))
#define GAS __attribute__((address_space(1)))
typedef unsigned short bf16_t;
typedef short bf16x8 __attribute__((ext_vector_type(8)));
typedef float f32x4 __attribute__((ext_vector_type(4)));
typedef unsigned u32x4 __attribute__((ext_vector_type(4)));
typedef unsigned u32x2 __attribute__((ext_vector_type(2)));

constexpr int DM = 1024, SEQ = 8192, NB = 4, DB = 32, DS = 4, PAST = 16384;
constexpr int NPR = NB * SEQ;
constexpr int NSR = DB * DS;
constexpr int MROWS = 33024;
constexpr int DIN = 6960, NIN_PAD = 7168, DMIX = 2048;
constexpr int C_Q = 0, C_KV = 1024, C_G = 1792, C_HC = 1840, C_BC = 2864, C_CC = 3888, C_ZA = 4912, C_ZC = 5936;
constexpr float LOG2E = 1.4426950408889634f;
constexpr float QSCALE = 0.125f * LOG2E;
constexpr float EPS = 1e-6f;
constexpr float NEG_INF = -__builtin_inff();

constexpr size_t O_YP = 0;
constexpr size_t O_YS = O_YP + (size_t)NPR * DM;
constexpr size_t O_PKC = O_YS + (size_t)NSR * DM;
constexpr size_t SZ_PKV = (size_t)NPR * 128;
constexpr size_t O_PKW = O_PKC + 4 * SZ_PKV;
constexpr size_t SZ_PW = (size_t)NB * 512 * 128;
constexpr size_t O_PCV = O_PKW + 2 * SZ_PW;
constexpr size_t O_SKC = O_PCV + (size_t)NB * 2 * 1024;
constexpr size_t SZ_SKV = (size_t)NSR * 128;
constexpr size_t O_SKW = O_SKC + 4 * SZ_SKV;
constexpr size_t SZ_SW = (size_t)DB * 512 * 128;
constexpr size_t O_SCV = O_SKW + 2 * SZ_SW;
constexpr size_t O_END = O_SCV + (size_t)DB * 2 * 1024;
static_assert(O_END == 55320576, "output size");

constexpr size_t MiB = 1u << 20;
constexpr size_t WS_CTL = 0, CTL_ZERO_BYTES = 1 * MiB;
constexpr size_t WS_MOD = 1 * MiB;
constexpr size_t WS_BT = 1 * MiB + 512 * 1024;
constexpr size_t WS_B1 = WS_BT + 16384;
constexpr size_t WS_WINT = 2 * MiB;
constexpr size_t WS_WOUTT = 18 * MiB;
constexpr size_t WS_W1T = 22 * MiB;
constexpr size_t WS_KCMPP = 24 * MiB;
constexpr size_t WS_VCMPT = 24 * MiB + 512 * 1024;
constexpr size_t WS_KCMPS = 25 * MiB;
constexpr size_t WS_VCMPS = 29 * MiB;
constexpr size_t WS_G = 33 * MiB;
constexpr size_t WS_RSQ = 40 * MiB;
constexpr size_t WS_H = 48 * MiB;
constexpr size_t WS_Q = 114 * MiB;
constexpr size_t WS_SZA = 179 * MiB;
constexpr size_t WS_U = 244 * MiB;
constexpr size_t WS_BCZ = 309 * MiB;
constexpr size_t WS_OWIN = 374 * MiB;
constexpr size_t WS_A2 = 439 * MiB;
constexpr size_t WS_KC = 568 * MiB;
constexpr size_t WS_VC = 576 * MiB, WS_KSL = 584 * MiB, WS_KW = 592 * MiB, WS_VSLT = 600 * MiB, WS_VWT = 608 * MiB;
constexpr size_t WS_PART = 616 * MiB;
constexpr size_t WS_END = 620 * MiB;

constexpr int LDS_CTL = 153600;
constexpr int LDS_BYTES = 153600 + 1024;

__device__ __forceinline__ unsigned pk_bf16(float lo, float hi) { unsigned r; asm("v_cvt_pk_bf16_f32 %0, %1, %2" : "=v"(r) : "v"(lo), "v"(hi)); return r; }
__device__ __forceinline__ float bf2f(unsigned short b) { return __uint_as_float(((unsigned)b) << 16); }
__device__ __forceinline__ float bflo(unsigned w) { return __uint_as_float(w << 16); }
__device__ __forceinline__ float bfhi(unsigned w) { return __uint_as_float(w & 0xffff0000u); }
__device__ __forceinline__ float fexp2(float x) { return __builtin_amdgcn_exp2f(x); }
__device__ __forceinline__ float frcp(float x) { return __builtin_amdgcn_rcpf(x); }
__device__ __forceinline__ float sigmoidf_(float x) { return frcp(1.f + fexp2(-LOG2E * x)); }
__device__ __forceinline__ float siluf_(float x) { return x * sigmoidf_(x); }
__device__ __forceinline__ float wave_sum(float v) {
#pragma unroll
    for (int o = 1; o < 64; o <<= 1) v += __shfl_xor(v, o);
    return v;
}
__device__ __forceinline__ float wave_max(float v) {
#pragma unroll
    for (int o = 1; o < 64; o <<= 1) v = fmaxf(v, __shfl_xor(v, o));
    return v;
}

__device__ __forceinline__ float xmax_16_32(float m) {
    auto a = __builtin_amdgcn_permlane16_swap(__float_as_uint(m), __float_as_uint(m), false, false); m = fmaxf(__uint_as_float(a[0]), __uint_as_float(a[1]));
    auto b = __builtin_amdgcn_permlane32_swap(__float_as_uint(m), __float_as_uint(m), false, false); return fmaxf(__uint_as_float(b[0]), __uint_as_float(b[1]));
}
__device__ __forceinline__ float xsum_16_32(float m) {
    auto a = __builtin_amdgcn_permlane16_swap(__float_as_uint(m), __float_as_uint(m), false, false); m = __uint_as_float(a[0]) + __uint_as_float(a[1]);
    auto b = __builtin_amdgcn_permlane32_swap(__float_as_uint(m), __float_as_uint(m), false, false); return __uint_as_float(b[0]) + __uint_as_float(b[1]);
}
__device__ __forceinline__ float dpp_sum8(float v) {
    v += __uint_as_float(__builtin_amdgcn_update_dpp(0, __float_as_uint(v), 0xB1, 0xf, 0xf, false));
    v += __uint_as_float(__builtin_amdgcn_update_dpp(0, __float_as_uint(v), 0x4E, 0xf, 0xf, false));
    v += __uint_as_float(__builtin_amdgcn_update_dpp(0, __float_as_uint(v), 0x141, 0xf, 0xf, false));
    return v;
}
#define LDS_WAIT() asm volatile("s_waitcnt lgkmcnt(0)" ::: "memory")
#define VM_WAIT() asm volatile("s_waitcnt vmcnt(0)" ::: "memory")

#define XB_TMO      128
#define XB_XCNT(j)  (256  + 64 * (j))
#define XB_XSUB(j)  (1280 + 64 * (j))
#define XB_XGEN(j)  (2304 + 64 * (j))
#define XB_TOP      3328
#define XB_TOPGEN   3392
#define XCD_BAR_WORDS 3456
#define XB_SPIN_CAP (1u << 18)
__device__ __forceinline__ unsigned xb_ld(unsigned* p)              { return __hip_atomic_load(p, __ATOMIC_RELAXED, __HIP_MEMORY_SCOPE_AGENT); }
__device__ __forceinline__ unsigned xb_add(unsigned* p, unsigned v) { return __hip_atomic_fetch_add(p, v, __ATOMIC_RELAXED, __HIP_MEMORY_SCOPE_AGENT); }
__device__ __forceinline__ unsigned xb_xcc_id() { return (unsigned)__builtin_amdgcn_s_getreg((3 << 11) | 20) & 0xFu; }
#define XB_SPIN(cond, bar) do { unsigned _sp = 0; while (cond) { __builtin_amdgcn_s_sleep(1); \
    if ((++_sp & 255u) == 0u) { if (xb_ld(&(bar)[XB_TMO])) break; if (_sp > XB_SPIN_CAP) { atomicAdd(&(bar)[XB_TMO], 1u); break; } } } } while (0)
struct XcdBarrier { unsigned* bar; unsigned x; volatile LAS unsigned* st; };
__device__ __forceinline__ XcdBarrier xcd_barrier_post(unsigned* bar, volatile LAS unsigned* st) {
    XcdBarrier b; b.bar = bar; b.x = xb_xcc_id(); b.st = st;
    if (threadIdx.x == 0) (void)xb_add(&bar[XB_XCNT(b.x)], 1u);
    return b;
}
__device__ __forceinline__ void xcd_barrier_complete(unsigned* bar, unsigned x, unsigned& nloc, unsigned& nx) {
    const unsigned G = gridDim.x * gridDim.y * gridDim.z;
    unsigned sum, cnt, mine, sp = 0u;
    for (;;) {
        sum = 0u; cnt = 0u; mine = 0u;
#pragma unroll
        for (unsigned j = 0; j < 16; ++j) { const unsigned c = xb_ld(&bar[XB_XCNT(j)]); sum += c; cnt += (c > 0u) ? 1u : 0u; mine = (j == x) ? c : mine; }
        if (sum == G) break;
        __builtin_amdgcn_s_sleep(1);
        if ((++sp & 255u) == 0u) { if (xb_ld(&bar[XB_TMO])) break; if (sp > XB_SPIN_CAP) { atomicAdd(&bar[XB_TMO], 1u); break; } }
    }
    nloc = mine > 0u ? mine : 1u; nx = cnt > 0u ? cnt : 1u;
}
__device__ __forceinline__ void xcd_barrier(const XcdBarrier& b) {
    asm volatile("s_waitcnt vmcnt(0)" ::: "memory");
    __syncthreads();
    if (threadIdx.x == 0) {
        unsigned* bar = b.bar;
        __builtin_amdgcn_s_waitcnt(0);
        unsigned nloc = b.st[0], nx = b.st[1];
        if (nloc == 0u) { xcd_barrier_complete(bar, b.x, nloc, nx); b.st[0] = nloc; b.st[1] = nx; }
        const unsigned old = xb_add(&bar[XB_XSUB(b.x)], 1u);
        const unsigned gen = old / nloc;
        if (old + 1u == (gen + 1u) * nloc) {
            __builtin_amdgcn_fence(__ATOMIC_RELEASE, "agent");
            asm volatile("s_waitcnt vmcnt(0)" ::: "memory");
            const unsigned og = xb_add(&bar[XB_TOP], 1u);
            const unsigned tg = og / nx;
            if (og + 1u == (tg + 1u) * nx) xb_add(&bar[XB_TOPGEN], 1u);
            else XB_SPIN(xb_ld(&bar[XB_TOPGEN]) == tg, bar);
            __builtin_amdgcn_fence(__ATOMIC_ACQUIRE, "agent");
            xb_add(&bar[XB_XGEN(b.x)], 1u);
            asm volatile("s_waitcnt vmcnt(0)" ::: "memory");
        } else {
            XB_SPIN(xb_ld(&bar[XB_XGEN(b.x)]) == gen, bar);
            __builtin_amdgcn_fence(__ATOMIC_ACQUIRE, "agent");
            asm volatile("s_waitcnt vmcnt(0)" ::: "memory");
        }
    }
    __syncthreads();
}

namespace pg8 {
constexpr int BM = 256, BK = 64, HALF = 128, HTB = HALF * BK * 2, STAGE_BYTES = 8 * HTB, NXCD = 8, WGM = 8;
__host__ __device__ __forceinline__ int lds_byte(int r, int c) { const int st = (r >> 4) * 2 + (c >> 5), rr = r & 15, cc = c & 31, ob = rr * 64 + cc * 2; return st * 1024 + (ob ^ (((ob >> 9) & 1) << 5)); }
__host__ __device__ __forceinline__ void stage_rc(int b, int& R, int& C) { const int st = b / 1024, sb = b % 1024, swz = sb ^ (((sb >> 9) & 1) << 5); R = (st >> 1) * 16 + swz / 64; C = (st & 1) * 32 + (swz % 64) / 2; }
struct Unit { int pm, pn; };
struct Gemm { const bf16_t* A; const bf16_t* Bt; int M, N, K; };
struct StaticOrder {
    int nM, nN, nwg, G, c;
    __host__ __device__ void init(int M, int N, int G_, int c_) { nM = M / BM; nN = N / BM; nwg = nM * nN; G = G_; c = c_; }
    __host__ __device__ bool next(int i, Unit& u) const {
        const long L = (long)i * G + c; if (L >= nwg) return false;
        int wgid = (int)L; { const int q = nwg / NXCD, r = nwg % NXCD, xcd = wgid % NXCD, off = wgid / NXCD; wgid = (xcd < r ? xcd * (q + 1) : r * (q + 1) + (xcd - r) * q) + off; }
        const int nig = WGM * nN, gid = wgid / nig, fm = gid * WGM, gsz = (nM - fm) < WGM ? (nM - fm) : WGM;
        u.pm = fm + ((wgid % nig) % gsz); u.pn = (wgid % nig) / gsz; return true;
    }
    __device__ __forceinline__ void a_ready(const Unit&) const {}
    __device__ __forceinline__ void done(const Unit&) const {}
};
template <class Epi, class Sched, bool ALIGN_EPI = false, bool SP2 = false>
__device__ __forceinline__ void gemm_phase(LAS unsigned char* lds, const Gemm g, const Sched& S, const Epi& E) {
    const int tid = threadIdx.x, wid = __builtin_amdgcn_readfirstlane(tid >> 6), lane = tid & 63, wr = wid >> 2, wc = wid & 3, fr = lane & 15, fq = lane >> 4;
    const int K = g.K, nt = K / BK;
    unsigned voffA[2], voffB[2];
#pragma unroll
    for (int i = 0; i < 2; ++i) { int R, C; stage_rc(tid * 16 + i * 8192, R, C); voffA[i] = (unsigned)(R * K + C) * 2u; voffB[i] = (unsigned)(R * K + C) * 2u; }
    const size_t kstep = (size_t)(BK * 2);
    const size_t hstep = (size_t)HALF * K * 2;
    const size_t tstep = 2 * hstep;
    const unsigned ldsw = (unsigned)wid * 1024u;
    const int aoff = lds_byte(wr * 64 + fr, fq * 8), boff = lds_byte(wc * 32 + fr, fq * 8);
#define PG8_SA(b, h) (((b) * 2 + (h)) * HTB)
#define PG8_SB(b, h) ((4 + (b) * 2 + (h)) * HTB)
#define PG8_STAGE(bufoff, gbase, voff) do { _Pragma("unroll") for (int _i = 0; _i < 2; ++_i) \
        __builtin_amdgcn_global_load_lds((const unsigned*)((const char*)(gbase) + (voff)[_i]), (LAS unsigned*)(lds + (bufoff) + ldsw + _i * 8192), 16, 0, 0); } while (0)
#define PG8_LDA(dst, b, h) do { _Pragma("unroll") for (int m = 0; m < 4; ++m) _Pragma("unroll") for (int k = 0; k < 2; ++k) dst[m][k] = *(const LAS bf16x8*)(lds + PG8_SA(b, h) + aoff + m * 2048 + k * 1024); } while (0)
#define PG8_LDB(dst, b, h) do { _Pragma("unroll") for (int n = 0; n < 2; ++n) _Pragma("unroll") for (int k = 0; k < 2; ++k) dst[n][k] = *(const LAS bf16x8*)(lds + PG8_SB(b, h) + boff + n * 2048 + k * 1024); } while (0)
#define PG8_MMA(ai, bj, At, Bt) do { __builtin_amdgcn_s_setprio(1); _Pragma("unroll") for (int m = 0; m < 4; ++m) _Pragma("unroll") for (int n = 0; n < 2; ++n) _Pragma("unroll") for (int k = 0; k < 2; ++k) \
        acc[ai][bj][m][n] = __builtin_amdgcn_mfma_f32_16x16x32_bf16(Bt[n][k], At[m][k], acc[ai][bj][m][n], 0, 0, 0); __builtin_amdgcn_s_setprio(0); } while (0)
#define PG8_WAIT_V(n) asm volatile("s_waitcnt vmcnt(" #n ")" ::: "memory")
#define PG8_WAIT_L(n) asm volatile("s_waitcnt lgkmcnt(" #n ")" ::: "memory")
#define PG8_BAR __builtin_amdgcn_s_barrier()
#define PG8_SCHED __builtin_amdgcn_sched_barrier(0)
    Unit cur, nxt; int ui = 0;
    if (!S.next(0, cur)) return;
    f32x4 acc[2][2][4][2];
#pragma unroll
    for (int a = 0; a < 2; ++a)
#pragma unroll
        for (int b = 0; b < 2; ++b)
#pragma unroll
            for (int m = 0; m < 4; ++m)
#pragma unroll
                for (int n = 0; n < 2; ++n) acc[a][b][m][n] = (f32x4){0.f, 0.f, 0.f, 0.f};
    bf16x8 At[4][2], B0[2][2], B1[2][2];
    const char* cA = (const char*)g.A + (size_t)cur.pm * tstep; const char* cB = (const char*)g.Bt + (size_t)cur.pn * tstep;
    S.a_ready(cur);
    if constexpr (SP2) {
        PG8_STAGE(PG8_SB(0, 0), cB, voffB); PG8_STAGE(PG8_SB(0, 1), cB + hstep, voffB); PG8_STAGE(PG8_SA(0, 0), cA, voffA); PG8_STAGE(PG8_SA(0, 1), cA + hstep, voffA);
        if (wr == 1) PG8_BAR;
        PG8_WAIT_V(2); PG8_BAR;
        PG8_STAGE(PG8_SB(1, 0), cB + kstep, voffB); PG8_STAGE(PG8_SA(1, 0), cA + kstep, voffA); PG8_STAGE(PG8_SB(1, 1), cB + hstep + kstep, voffB);
        PG8_WAIT_V(6); PG8_BAR;
    } else {
        PG8_STAGE(PG8_SB(0, 0), cB, voffB); PG8_STAGE(PG8_SA(0, 0), cA, voffA); PG8_STAGE(PG8_SB(0, 1), cB + hstep, voffB); PG8_STAGE(PG8_SA(0, 1), cA + hstep, voffA);
        if (wr == 1) PG8_BAR;
        PG8_WAIT_V(4); PG8_BAR;
        PG8_STAGE(PG8_SB(1, 0), cB + kstep, voffB); PG8_STAGE(PG8_SA(1, 0), cA + kstep, voffA); PG8_STAGE(PG8_SB(1, 1), cB + hstep + kstep, voffB);
        PG8_WAIT_V(6); PG8_BAR;
    }
    for (;;) {
        const bool has_next = S.next(ui + 1, nxt);
        const char* nA = has_next ? (const char*)g.A + (size_t)nxt.pm * tstep : cA; const char* nB = has_next ? (const char*)g.Bt + (size_t)nxt.pn * tstep : cB;
        for (int t = 0; t < nt; t += 2) {
            const bool last = (t == nt - 2);
            const char* a1 = cA + (size_t)(t + 1) * kstep;
            const char* a2 = last ? nA : cA + (size_t)(t + 2) * kstep; const char* b2 = last ? nB : cB + (size_t)(t + 2) * kstep;
            const char* a3 = a2 + kstep; const char* b3 = b2 + kstep;
            if (last && has_next) S.a_ready(nxt);
            if constexpr (SP2) {
            PG8_LDB(B0, 0, 0); PG8_LDB(B1, 0, 1); PG8_SCHED; PG8_LDA(At, 0, 0); PG8_STAGE(PG8_SA(1, 1), a1 + hstep, voffA);
            PG8_WAIT_V(8); PG8_WAIT_L(0); PG8_BAR; PG8_MMA(0, 0, At, B0); PG8_MMA(0, 1, At, B1); PG8_BAR; PG8_SCHED;
            PG8_LDA(At, 0, 1); PG8_STAGE(PG8_SB(0, 0), b2, voffB); PG8_STAGE(PG8_SB(0, 1), b2 + hstep, voffB); PG8_STAGE(PG8_SA(0, 0), a2, voffA);
            PG8_WAIT_V(8); PG8_WAIT_L(0); PG8_BAR; PG8_MMA(1, 0, At, B0); PG8_MMA(1, 1, At, B1); PG8_BAR; PG8_SCHED;
            PG8_LDB(B0, 1, 0); PG8_LDB(B1, 1, 1); PG8_SCHED; PG8_LDA(At, 1, 0); PG8_STAGE(PG8_SA(0, 1), a2 + hstep, voffA);
            PG8_WAIT_V(8); PG8_WAIT_L(0); PG8_BAR; PG8_MMA(0, 0, At, B0); PG8_MMA(0, 1, At, B1); PG8_BAR; PG8_SCHED;
            PG8_LDA(At, 1, 1); PG8_STAGE(PG8_SB(1, 0), b3, voffB); PG8_STAGE(PG8_SB(1, 1), b3 + hstep, voffB); PG8_STAGE(PG8_SA(1, 0), a3, voffA);
            PG8_WAIT_V(8); PG8_WAIT_L(0); PG8_BAR; PG8_MMA(1, 0, At, B0); PG8_MMA(1, 1, At, B1); PG8_BAR; PG8_SCHED;
            } else {
            PG8_LDB(B0, 0, 0); PG8_SCHED; PG8_LDA(At, 0, 0); PG8_STAGE(PG8_SA(1, 1), a1 + hstep, voffA);
            PG8_WAIT_L(8); PG8_BAR; PG8_WAIT_L(0); PG8_MMA(0, 0, At, B0); PG8_BAR; PG8_SCHED;
            PG8_LDB(B1, 0, 1); PG8_STAGE(PG8_SB(0, 0), b2, voffB);
            PG8_BAR; PG8_WAIT_L(0); PG8_MMA(0, 1, At, B1); PG8_BAR;
            PG8_LDA(At, 0, 1); PG8_STAGE(PG8_SA(0, 0), a2, voffA);
            PG8_BAR; PG8_WAIT_L(0); PG8_MMA(1, 0, At, B0); PG8_BAR; PG8_SCHED;
            PG8_STAGE(PG8_SB(0, 1), b2 + hstep, voffB);
            PG8_WAIT_V(6); PG8_BAR; PG8_MMA(1, 1, At, B1); PG8_BAR;
            PG8_LDB(B0, 1, 0); PG8_SCHED; PG8_LDA(At, 1, 0); PG8_STAGE(PG8_SA(0, 1), a2 + hstep, voffA);
            PG8_WAIT_L(8); PG8_BAR; PG8_WAIT_L(0); PG8_MMA(0, 0, At, B0); PG8_BAR; PG8_SCHED;
            PG8_LDB(B1, 1, 1); PG8_STAGE(PG8_SB(1, 0), b3, voffB);
            PG8_BAR; PG8_WAIT_L(0); PG8_MMA(0, 1, At, B1); PG8_BAR;
            PG8_LDA(At, 1, 1); PG8_STAGE(PG8_SA(1, 0), a3, voffA);
            PG8_BAR; PG8_WAIT_L(0); PG8_MMA(1, 0, At, B0); PG8_BAR; PG8_SCHED;
            PG8_STAGE(PG8_SB(1, 1), b3 + hstep, voffB);
            PG8_WAIT_V(6); PG8_BAR; PG8_MMA(1, 1, At, B1); PG8_BAR;
            }
        }
        if constexpr (ALIGN_EPI) { if (wr == 0) PG8_BAR; }
        E(acc, cur, wr, wc, fr, fq); S.done(cur);
        if (!has_next) break;
#pragma unroll
        for (int a = 0; a < 2; ++a)
#pragma unroll
            for (int b = 0; b < 2; ++b)
#pragma unroll
                for (int m = 0; m < 4; ++m)
#pragma unroll
                    for (int n = 0; n < 2; ++n) acc[a][b][m][n] = (f32x4){0.f, 0.f, 0.f, 0.f};
        cur = nxt; cA = nA; cB = nB; ++ui;
        if constexpr (ALIGN_EPI) { if (wr == 1) PG8_BAR; }
    }
    PG8_WAIT_V(0);
    if constexpr (!ALIGN_EPI) { if (wr == 0) PG8_BAR; }
    PG8_BAR;
#undef PG8_SA
#undef PG8_SB
#undef PG8_STAGE
#undef PG8_LDA
#undef PG8_LDB
#undef PG8_MMA
#undef PG8_WAIT_V
#undef PG8_WAIT_L
#undef PG8_BAR
#undef PG8_SCHED
}
}

struct Args {
    const float* x_prompt; const float* x_sample;
    const float* cache_k_cmp; const float* cache_v_cmp; const float* cache_k_slc; const float* cache_v_slc;
    const float* cache_k_win; const float* cache_v_win; const float* state_conv; const int* page_table;
    const float* c_prompt; const float* c_sample; const float* ada_w; const float* ada_b; const float* norm_g; const float* w_in;
    const float* cmp_pe_k; const float* cmp_w1_k; const float* cmp_w2_k; const float* cmp_pe_v; const float* cmp_w1_v; const float* cmp_w2_v;
    const float* conv_w; const float* w_out; const float* rel_bias; const float* final_g;
    float* out; unsigned char* ws; int ph_lo, ph_hi;
};
struct Frame {
    LAS unsigned char* lds; int tid, lane, wave, G, bid;
};

__host__ __device__ __forceinline__ int vslot32(int kk) { return kk < 16 ? 8 * (kk >> 2) + (kk & 3) : 8 * ((kk - 16) >> 2) + 4 + (kk & 3); }
__host__ __device__ __forceinline__ int inv_perm32(int lo) { return 16 * ((lo >> 2) & 1) + 4 * (lo >> 3) + (lo & 3); }

__device__ __forceinline__ void transpose_item(const float* W, int ldw, int src0, int nvalid, bf16_t* WT, int K, int dst0, bool perm, int k0, LAS float* scr, int lane) {
    const int c = lane & 31;
#pragma unroll 8
    for (int i = 0; i < 32; ++i) { const int kk = 2 * i + (lane >> 5); scr[kk * 33 + c] = (c < nvalid) ? W[(size_t)(k0 + kk) * ldw + src0 + c] : 0.f; }
    LDS_WAIT(); asm volatile("" ::: "memory");
    const int c8 = lane & 7;
#pragma unroll
    for (int j = 0; j < 4; ++j) { const int n = (lane >> 3) + 8 * j; const LAS float* s = scr + (8 * c8) * 33 + n;
        u32x4 o; o.x = pk_bf16(s[0 * 33], s[1 * 33]); o.y = pk_bf16(s[2 * 33], s[3 * 33]); o.z = pk_bf16(s[4 * 33], s[5 * 33]); o.w = pk_bf16(s[6 * 33], s[7 * 33]);
        const int dn = perm ? inv_perm32(n) : n;
        *(u32x4*)(WT + (size_t)(dst0 + dn) * K + k0 + 8 * c8) = o; }
    LDS_WAIT(); asm volatile("" ::: "memory");
}
__device__ __forceinline__ void win_group_src(int pg, int& src0, int& nvalid) {
    const int pn = pg >> 3, bj = (pg >> 2) & 1, wc = pg & 3; nvalid = 32;
    if (pn < 4) src0 = C_Q + 256 * pn + 128 * bj + 32 * wc;
    else if (pn < 8) src0 = C_ZA + 256 * (pn - 4) + 128 * bj + 32 * wc;
    else if (pn < 11) src0 = C_KV + 128 * (2 * (pn - 8) + bj) + 32 * wc;
    else if (pn == 11) { src0 = C_G + 32 * wc; nvalid = bj ? 0 : (wc == 0 ? 32 : (wc == 1 ? 16 : 0)); if (nvalid == 0) src0 = 0; }
    else if (pn < 20) src0 = (bj ? C_CC : C_HC) + 128 * (pn - 12) + 32 * wc;
    else src0 = (bj ? C_ZC : C_BC) + 128 * (pn - 20) + 32 * wc;
}

__device__ __forceinline__ void p0a(const Args& a, Frame& F) {
    unsigned char* ws = a.ws;
    {
        LAS float* scr = (LAS float*)(F.lds + F.wave * 8704);
        const int gw = F.bid * 8 + F.wave, NGW = F.G * 8;
        constexpr int I_IN = 224 * 16, I_OUT = 32 * 32, I_W1 = 4 * 64;
        constexpr int NITEMS = I_IN + I_OUT + 2 * I_W1;
        for (int it = gw; it < NITEMS; it += NGW) {
            int r = it;
            if (r < I_IN) { const int pg = r >> 4, kb = r & 15; int src0, nv; win_group_src(pg, src0, nv);
                transpose_item(a.w_in, DIN, src0, nv, (bf16_t*)(ws + WS_WINT), DM, pg * 32, true, kb * 64, scr, F.lane); continue; }
            r -= I_IN;
            if (r < I_OUT) { const int pg = r >> 5, kb = r & 31;
                transpose_item(a.w_out, DM, pg * 32, 32, (bf16_t*)(ws + WS_WOUTT), DMIX, pg * 32, true, kb * 64, scr, F.lane); continue; }
            r -= I_OUT;
            const int kv = r >= I_W1; if (kv) r -= I_W1;
            { const int pg = r >> 6, kb = r & 63;
              transpose_item(kv ? a.cmp_w1_v : a.cmp_w1_k, 128, pg * 32, 32, (bf16_t*)(ws + WS_W1T) + (size_t)kv * 128 * 4096, 4096, pg * 32, false, kb * 64, scr, F.lane); }
        }
    }
    __syncthreads();
    {
        LAS float* CS = (LAS float*)(F.lds) + F.wave * (18 * 128);
        LAS float* RED = (LAS float*)(F.lds + 73728);
        float* MOD = (float*)(ws + WS_MOD);
        for (int job = F.bid; job < 96; job += F.G) {
            const int cg = job >> 1, rh = job & 1, n = cg * 64 + F.lane, kb = F.wave * 128;
            for (int i = F.lane; i < 18 * 128; i += 64) { const int r = rh * 18 + i / 128, k = kb + (i & 127);
                CS[i] = (r < 4) ? a.c_prompt[r * DM + k] : a.c_sample[(r - 4) * DM + k]; }
            LDS_WAIT(); asm volatile("" ::: "memory");
            float acc[18];
#pragma unroll
            for (int r = 0; r < 18; ++r) acc[r] = 0.f;
            for (int k16 = 0; k16 < 128; k16 += 16) {
                float wv[16];
#pragma unroll
                for (int i = 0; i < 16; ++i) wv[i] = a.ada_w[(size_t)(kb + k16 + i) * 3072 + n];
#pragma unroll
                for (int q = 0; q < 4; ++q)
#pragma unroll
                    for (int r = 0; r < 18; ++r) { const f32x4 c4 = *(const LAS f32x4*)(CS + r * 128 + k16 + 4 * q); acc[r] += c4.x * wv[4 * q] + c4.y * wv[4 * q + 1] + c4.z * wv[4 * q + 2] + c4.w * wv[4 * q + 3]; }
            }
#pragma unroll
            for (int r = 0; r < 18; ++r) RED[(F.wave * 18 + r) * 64 + F.lane] = acc[r];
            __syncthreads();
            for (int o = F.tid; o < 18 * 64; o += 512) { const int r = o >> 6, l = o & 63; float s = 0.f;
#pragma unroll
                for (int w = 0; w < 8; ++w) s += RED[(w * 18 + r) * 64 + l];
                MOD[(rh * 18 + r) * 3072 + cg * 64 + l] = s + a.ada_b[cg * 64 + l]; }
            __syncthreads();
        }
    }
    if (F.bid == F.G - 3) {
        float* BT = (float*)(ws + WS_BT);
        for (int i = F.tid; i < 129 * 16; i += 512) { const int d = i >> 4, hh = i & 15; int bk;
            if (d < 16) bk = d; else { int lg = 16 + (int)(log((double)d / 16.0) / log(8.0) * 16.0); bk = lg < 31 ? lg : 31; }
            BT[i] = a.rel_bias[bk * 16 + hh] * LOG2E; }
    }
    {
        const size_t per = (size_t)508 * 128 / 4;
        const size_t total = 2 * DB * per;
        for (size_t i = (size_t)F.bid * 512 + F.tid; i < total; i += (size_t)F.G * 512) {
            const int t = (int)(i / (DB * per)); const size_t r = i % (DB * per); const int sb = (int)(r / per); const size_t o = r % per;
            const f32x4* src = (const f32x4*)((t ? a.cache_v_win : a.cache_k_win) + ((size_t)sb * 512 + 4) * 128) + o;
            f32x4* dst = (f32x4*)(a.out + O_SKW + (size_t)t * SZ_SW + (size_t)sb * 512 * 128) + o;
            *dst = *src;
        }
    }
}

__device__ __forceinline__ void p0b_rows(const Args& a, Frame& F) {
    const float* MOD = (const float*)(a.ws + WS_MOD); bf16_t* H = (bf16_t*)(a.ws + WS_H);
    const int gw = F.bid * 8 + F.wave, NGW = F.G * 8;
    for (int row = gw; row < MROWS; row += NGW) {
        unsigned long long* o8 = (unsigned long long*)(H + (size_t)row * DM) + F.lane;
        if (row >= NPR + NSR) {
#pragma unroll
            for (int j = 0; j < 4; ++j) o8[64 * j] = 0ull;
            continue; }
        const float* xr; int mr;
        if (row < NPR) { xr = a.x_prompt + (size_t)row * DM; mr = row >> 13; } else { xr = a.x_sample + (size_t)(row - NPR) * DM; mr = 4 + ((row - NPR) >> 2); }
        const f32x4* x4 = (const f32x4*)xr + F.lane;
        f32x4 v[4]; float s = 0.f;
#pragma unroll
        for (int j = 0; j < 4; ++j) { v[j] = x4[64 * j]; s += (v[j].x * v[j].x + v[j].y * v[j].y) + (v[j].z * v[j].z + v[j].w * v[j].w); }
        const float rstd = 1.f / sqrtf(wave_sum(s) * (1.f / DM) + EPS);
        const float* shift = MOD + (size_t)mr * 3072; const float* scale = shift + 1024;
#pragma unroll
        for (int j = 0; j < 4; ++j) { const int c = 4 * F.lane + 256 * j;
            const f32x4 g = *(const f32x4*)(a.norm_g + c), sc = *(const f32x4*)(scale + c), sh = *(const f32x4*)(shift + c);
            const f32x4 y = (v[j] * rstd * g) * (sc + 1.f) + sh;
            o8[64 * j] = (unsigned long long)pk_bf16(y.x, y.y) | ((unsigned long long)pk_bf16(y.z, y.w) << 32); }
    }
}

__device__ __forceinline__ void emit_in_row(float* out, unsigned char* ws, int pn, int row, int lc0, const f32x4 a0, const f32x4 a1, const f32x4 b0, const f32x4 b1) {
    if (pn < 4) {
                    bf16_t* d = (bf16_t*)(ws + WS_Q) + (size_t)row * DM + 256 * pn + lc0;
                    u32x4 w0, w1;
                    w0.x = pk_bf16(a0.x * QSCALE, a0.y * QSCALE); w0.y = pk_bf16(a0.z * QSCALE, a0.w * QSCALE); w0.z = pk_bf16(a1.x * QSCALE, a1.y * QSCALE); w0.w = pk_bf16(a1.z * QSCALE, a1.w * QSCALE);
                    w1.x = pk_bf16(b0.x * QSCALE, b0.y * QSCALE); w1.y = pk_bf16(b0.z * QSCALE, b0.w * QSCALE); w1.z = pk_bf16(b1.x * QSCALE, b1.y * QSCALE); w1.w = pk_bf16(b1.z * QSCALE, b1.w * QSCALE);
                    *(u32x4*)d = w0; *(u32x4*)(d + 128) = w1;
                } else if (pn < 8) {
                    bf16_t* d = (bf16_t*)(ws + WS_SZA) + (size_t)row * DM + 256 * (pn - 4) + lc0;
                    u32x4 w0, w1;
                    w0.x = pk_bf16(siluf_(a0.x), siluf_(a0.y)); w0.y = pk_bf16(siluf_(a0.z), siluf_(a0.w)); w0.z = pk_bf16(siluf_(a1.x), siluf_(a1.y)); w0.w = pk_bf16(siluf_(a1.z), siluf_(a1.w));
                    w1.x = pk_bf16(siluf_(b0.x), siluf_(b0.y)); w1.y = pk_bf16(siluf_(b0.z), siluf_(b0.w)); w1.z = pk_bf16(siluf_(b1.x), siluf_(b1.y)); w1.w = pk_bf16(siluf_(b1.z), siluf_(b1.w));
                    *(u32x4*)d = w0; *(u32x4*)(d + 128) = w1;
                } else if (pn < 11) {
#pragma unroll
                    for (int bj = 0; bj < 2; ++bj) {
                        const int ti = 2 * (pn - 8) + bj; const f32x4 v0 = bj ? b0 : a0, v1 = bj ? b1 : a1;
                        float* fo = nullptr;
                        if (row < NPR) {
                            const int s = row & (SEQ - 1), b = row >> 13;
                            if (ti < 4) fo = out + O_PKC + (size_t)ti * SZ_PKV + (size_t)row * 128 + lc0;
                            else if (s >= SEQ - 512) fo = out + O_PKW + (size_t)(ti - 4) * SZ_PW + ((size_t)b * 512 + (s - (SEQ - 512))) * 128 + lc0;
                            if (ti == 0 || ti == 1 || ti == 2 || ti == 4) {
                                const size_t base = ti == 0 ? WS_KC : ti == 1 ? WS_VC : ti == 2 ? WS_KSL : WS_KW;
                                u32x4 w; w.x = pk_bf16(v0.x, v0.y); w.y = pk_bf16(v0.z, v0.w); w.z = pk_bf16(v1.x, v1.y); w.w = pk_bf16(v1.z, v1.w);
                                *(u32x4*)((bf16_t*)(ws + base) + (size_t)row * 128 + lc0) = w;
                            } else {
                                bf16_t* vt = (bf16_t*)(ws + (ti == 3 ? WS_VSLT : WS_VWT));
                                const int g = lc0 >> 6, d0 = lc0 & 63, blk = s >> 6, kk = s & 63, slot = (kk & 32) + vslot32(kk & 31);
                                bf16_t* p = vt + (((size_t)(b * 2 + g) * 128 + blk) * 64 + d0) * 64 + slot;
                                const unsigned w0 = pk_bf16(v0.x, v0.y), w1 = pk_bf16(v0.z, v0.w), w2 = pk_bf16(v1.x, v1.y), w3 = pk_bf16(v1.z, v1.w);
                                p[0] = (bf16_t)w0; p[64] = (bf16_t)(w0 >> 16); p[128] = (bf16_t)w1; p[192] = (bf16_t)(w1 >> 16);
                                p[256] = (bf16_t)w2; p[320] = (bf16_t)(w2 >> 16); p[384] = (bf16_t)w3; p[448] = (bf16_t)(w3 >> 16);
                            }
                        } else {
                            const int sr = row - NPR, sb = sr >> 2, t = sr & 3;
                            if (ti < 4) fo = out + O_SKC + (size_t)ti * SZ_SKV + (size_t)sr * 128 + lc0;
                            else fo = out + O_SKW + (size_t)(ti - 4) * SZ_SW + ((size_t)sb * 512 + 508 + t) * 128 + lc0;
                        }
                        if (fo) { *(f32x4*)fo = v0; *(f32x4*)(fo + 4) = v1; }
                    }
                } else if (pn == 11) {
                    if (lc0 < 48) { float* d = (float*)(ws + WS_G) + (size_t)row * 48 + lc0;
                        *(f32x4*)d = (f32x4){sigmoidf_(a0.x), sigmoidf_(a0.y), sigmoidf_(a0.z), sigmoidf_(a0.w)};
                        *(f32x4*)(d + 4) = (f32x4){sigmoidf_(a1.x), sigmoidf_(a1.y), sigmoidf_(a1.z), sigmoidf_(a1.w)}; }
                } else if (pn < 20) {
                    const int ch = 128 * (pn - 12) + lc0; const f32x4 u0 = a0 * b0, u1 = a1 * b1;
                    u32x4 w; w.x = pk_bf16(u0.x, u0.y); w.y = pk_bf16(u0.z, u0.w); w.z = pk_bf16(u1.x, u1.y); w.w = pk_bf16(u1.z, u1.w);
                    *(u32x4*)((bf16_t*)(ws + WS_U) + (size_t)row * DM + ch) = w;
                    float* fo = nullptr;
                    if (row < NPR) { const int s = row & (SEQ - 1); if (s >= SEQ - 2) fo = out + O_PCV + ((size_t)(row >> 13) * 2 + (s - (SEQ - 2))) * 1024 + ch; }
                    else { const int sr = row - NPR, t = sr & 3; if (t >= 2) fo = out + O_SCV + ((size_t)(sr >> 2) * 2 + (t - 2)) * 1024 + ch; }
                    if (fo) { *(f32x4*)fo = u0; *(f32x4*)(fo + 4) = u1; }
                } else {
                    const int ch = 128 * (pn - 20) + lc0;
                    u32x4 w; w.x = pk_bf16(a0.x * siluf_(b0.x), a0.y * siluf_(b0.y)); w.y = pk_bf16(a0.z * siluf_(b0.z), a0.w * siluf_(b0.w));
                    w.z = pk_bf16(a1.x * siluf_(b1.x), a1.y * siluf_(b1.y)); w.w = pk_bf16(a1.z * siluf_(b1.z), a1.w * siluf_(b1.w));
                    *(u32x4*)((bf16_t*)(ws + WS_BCZ) + (size_t)row * DM + ch) = w;
                }
}
struct EpiIn {
    float* out; unsigned char* ws;
    __device__ __forceinline__ void operator()(const f32x4 (&acc)[2][2][4][2], const pg8::Unit& u, int wr, int wc, int fr, int fq) const {
        const int pn = u.pn, lc0 = wc * 32 + fq * 8;
#pragma unroll
        for (int ai = 0; ai < 2; ++ai)
#pragma unroll
            for (int m = 0; m < 4; ++m) {
                const int row = u.pm * 256 + ai * 128 + wr * 64 + m * 16 + fr;
                emit_in_row(out, ws, pn, row, lc0, acc[ai][0][m][0], acc[ai][0][m][1], acc[ai][1][m][0], acc[ai][1][m][1]);
            }
    }
};
__device__ __forceinline__ void sample_inproj_job(const Args& a, Frame& F, int job) {
    const int pn = job >> 2, wc = job & 3, w = F.wave, lane = F.lane, fr = lane & 15, fq = lane >> 4;
    const bf16_t* hp = (const bf16_t*)(a.ws + WS_H) + (size_t)(NPR + 16 * w + fr) * DM + 8 * fq;
    const bf16_t* wp = (const bf16_t*)(a.ws + WS_WINT) + (size_t)(256 * pn + 32 * wc + fr) * DM + 8 * fq;
    f32x4 acc[2][2];
#pragma unroll
    for (int i = 0; i < 2; ++i)
#pragma unroll
        for (int j = 0; j < 2; ++j) acc[i][j] = (f32x4){0.f, 0.f, 0.f, 0.f};
#pragma unroll 8
    for (int s = 0; s < 32; ++s) {
        const bf16x8 hf = *(const bf16x8*)(hp + 32 * s);
#pragma unroll
        for (int bj = 0; bj < 2; ++bj)
#pragma unroll
            for (int n = 0; n < 2; ++n) { const bf16x8 wf = *(const bf16x8*)(wp + (size_t)(128 * bj + 16 * n) * DM + 32 * s); acc[bj][n] = __builtin_amdgcn_mfma_f32_16x16x32_bf16(wf, hf, acc[bj][n], 0, 0, 0); }
    }
    emit_in_row(a.out, a.ws, pn, NPR + 16 * w + fr, wc * 32 + fq * 8, acc[0][0], acc[0][1], acc[1][0], acc[1][1]);
}

struct EpiOut {
    float* out; unsigned char* ws; const float* x_prompt;
    __device__ __forceinline__ void operator()(const f32x4 (&acc)[2][2][4][2], const pg8::Unit& u, int wr, int wc, int fr, int fq) const {
        const int pn = u.pn, lc0 = wc * 32 + fq * 8; const float* MOD = (const float*)(ws + WS_MOD); float* RSQ = (float*)(ws + WS_RSQ);
#pragma unroll
        for (int ai = 0; ai < 2; ++ai)
#pragma unroll
            for (int m = 0; m < 4; ++m) {
                const int row = u.pm * 256 + ai * 128 + wr * 64 + m * 16 + fr; float ss = 0.f;
                const float* xr = x_prompt + (size_t)row * DM; float* yr = out + O_YP + (size_t)row * DM;
                const float* gate = MOD + (size_t)(row >> 13) * 3072 + 2048;
#pragma unroll
                for (int bj = 0; bj < 2; ++bj)
#pragma unroll
                    for (int n = 0; n < 2; ++n) { const int c = 256 * pn + 128 * bj + lc0 + 4 * n;
                        const f32x4 o = *(const f32x4*)(xr + c) + *(const f32x4*)(gate + c) * acc[ai][bj][m][n];
                        ss += (o.x * o.x + o.y * o.y) + (o.z * o.z + o.w * o.w);
                        *(f32x4*)(yr + c) = o; }
                ss += __shfl_xor(ss, 16); ss += __shfl_xor(ss, 32);
                if (fq == 0) RSQ[(size_t)row * 16 + pn * 4 + wc] = ss;
            }
    }
};
__device__ __forceinline__ void sample_outproj_job(const Args& a, Frame& F, int job) {
    const int kq4 = job >> 4, pn = (job >> 2) & 3, wc = job & 3, w = F.wave, lane = F.lane, fr = lane & 15, fq = lane >> 4;
    const bf16_t* ap = (const bf16_t*)(a.ws + WS_A2) + (size_t)(NPR + 16 * w + fr) * DMIX + kq4 * 512 + 8 * fq;
    const bf16_t* wp = (const bf16_t*)(a.ws + WS_WOUTT) + (size_t)(256 * pn + 32 * wc + fr) * DMIX + kq4 * 512 + 8 * fq;
    f32x4 acc[2][2];
#pragma unroll
    for (int i = 0; i < 2; ++i)
#pragma unroll
        for (int j = 0; j < 2; ++j) acc[i][j] = (f32x4){0.f, 0.f, 0.f, 0.f};
#pragma unroll 8
    for (int s = 0; s < 16; ++s) {
        const bf16x8 af = *(const bf16x8*)(ap + 32 * s);
#pragma unroll
        for (int bj = 0; bj < 2; ++bj)
#pragma unroll
            for (int n = 0; n < 2; ++n) { const bf16x8 wf = *(const bf16x8*)(wp + (size_t)(128 * bj + 16 * n) * DMIX + 32 * s); acc[bj][n] = __builtin_amdgcn_mfma_f32_16x16x32_bf16(wf, af, acc[bj][n], 0, 0, 0); }
    }
    float* P = (float*)(a.ws + WS_PART) + ((size_t)kq4 * NSR + 16 * w + fr) * DM + 256 * pn + wc * 32 + fq * 8;
#pragma unroll
    for (int bj = 0; bj < 2; ++bj)
#pragma unroll
        for (int n = 0; n < 2; ++n) *(f32x4*)(P + 128 * bj + 4 * n) = acc[bj][n];
}

__device__ __forceinline__ void p5_rows(const Args& a, Frame& F) {
    const float* RSQ = (const float*)(a.ws + WS_RSQ); const float* MOD = (const float*)(a.ws + WS_MOD); const float* PART = (const float*)(a.ws + WS_PART);
    const int gw = F.bid * 8 + F.wave, NGW = F.G * 8;
    for (int row = gw; row < NPR + NSR; row += NGW) {
        if (row < NPR) {
            float s = (F.lane < 16) ? RSQ[(size_t)row * 16 + F.lane] : 0.f;
            s = wave_sum(s);
            const float rstd = 1.f / sqrtf(s * (1.f / DM) + EPS);
            f32x4* y4 = (f32x4*)(a.out + O_YP + (size_t)row * DM) + F.lane;
#pragma unroll
            for (int j = 0; j < 4; ++j) { const f32x4 g = *((const f32x4*)a.final_g + F.lane + 64 * j); y4[64 * j] = y4[64 * j] * rstd * g; }
        } else {
            const int sr = row - NPR; f32x4 o[4]; float s = 0.f;
#pragma unroll
            for (int j = 0; j < 4; ++j) { const int c = 4 * F.lane + 256 * j;
                f32x4 acc = *(const f32x4*)(PART + (size_t)sr * DM + c);
#pragma unroll
                for (int k = 1; k < 4; ++k) acc = acc + *(const f32x4*)(PART + ((size_t)k * NSR + sr) * DM + c);
                o[j] = *(const f32x4*)(a.x_sample + (size_t)sr * DM + c) + *(const f32x4*)(MOD + (size_t)(4 + (sr >> 2)) * 3072 + 2048 + c) * acc;
                s += (o[j].x * o[j].x + o[j].y * o[j].y) + (o[j].z * o[j].z + o[j].w * o[j].w); }
            const float rstd = 1.f / sqrtf(wave_sum(s) * (1.f / DM) + EPS);
            f32x4* y4 = (f32x4*)(a.out + O_YS + (size_t)sr * DM) + F.lane;
#pragma unroll
            for (int j = 0; j < 4; ++j) { const f32x4 g = *((const f32x4*)a.final_g + F.lane + 64 * j); y4[64 * j] = o[j] * rstd * g; }
        }
    }
}

__device__ __forceinline__ void unpack8(const u32x4 w, float (&f)[8]) { f[0] = bflo(w.x); f[1] = bfhi(w.x); f[2] = bflo(w.y); f[3] = bfhi(w.y); f[4] = bflo(w.z); f[5] = bfhi(w.z); f[6] = bflo(w.w); f[7] = bfhi(w.w); }
__device__ __forceinline__ void conv_rows(const Args& a, Frame& F) {
    const bf16_t* U = (const bf16_t*)(a.ws + WS_U); const bf16_t* BCZ = (const bf16_t*)(a.ws + WS_BCZ); bf16_t* A2 = (bf16_t*)(a.ws + WS_A2);
    constexpr int CH = 32; const int nitem = (NPR / CH) * 128;
    for (int it = F.bid * 512 + F.tid; it < nitem; it += F.G * 512) {
        const int c = (it & 127) * 8, r0 = (it >> 7) * CH;
        float w0[8], w1[8], w2[8], um2[8], um1[8];
#pragma unroll
        for (int j = 0; j < 8; ++j) { w0[j] = a.conv_w[c + j]; w1[j] = a.conv_w[1024 + c + j]; w2[j] = a.conv_w[2048 + c + j]; um2[j] = 0.f; um1[j] = 0.f; }
        if ((r0 & (SEQ - 1)) != 0) { unpack8(*(const u32x4*)(U + (size_t)(r0 - 2) * DM + c), um2); unpack8(*(const u32x4*)(U + (size_t)(r0 - 1) * DM + c), um1); }
#pragma unroll 4
        for (int r = r0; r < r0 + CH; ++r) {
            float u0[8], bz[8], o[8];
            unpack8(*(const u32x4*)(U + (size_t)r * DM + c), u0); unpack8(*(const u32x4*)(BCZ + (size_t)r * DM + c), bz);
#pragma unroll
            for (int j = 0; j < 8; ++j) { o[j] = (w0[j] * um2[j] + w1[j] * um1[j] + w2[j] * u0[j]) * bz[j]; um2[j] = um1[j]; um1[j] = u0[j]; }
            *(u32x4*)(A2 + (size_t)r * DMIX + 1024 + c) = (u32x4){pk_bf16(o[0], o[1]), pk_bf16(o[2], o[3]), pk_bf16(o[4], o[5]), pk_bf16(o[6], o[7])};
        }
    }
    for (int it = F.bid * 512 + F.tid; it < NSR * 128; it += F.G * 512) {
        const int sr = it >> 7, c = (it & 127) * 8, row = NPR + sr, t = sr & 3; const float* st = a.state_conv + (size_t)(sr >> 2) * 2 * 1024 + c;
        float u0[8], bz[8], um1[8], um2[8], o[8];
        unpack8(*(const u32x4*)(U + (size_t)row * DM + c), u0); unpack8(*(const u32x4*)(BCZ + (size_t)row * DM + c), bz);
        if (t >= 1) unpack8(*(const u32x4*)(U + (size_t)(row - 1) * DM + c), um1); else {
#pragma unroll
            for (int j = 0; j < 8; ++j) um1[j] = st[1024 + j]; }
        if (t >= 2) unpack8(*(const u32x4*)(U + (size_t)(row - 2) * DM + c), um2); else {
#pragma unroll
            for (int j = 0; j < 8; ++j) um2[j] = st[(t == 1 ? 1024 : 0) + j]; }
#pragma unroll
        for (int j = 0; j < 8; ++j) o[j] = (a.conv_w[c + j] * um2[j] + a.conv_w[1024 + c + j] * um1[j] + a.conv_w[2048 + c + j] * u0[j]) * bz[j];
        *(u32x4*)(A2 + (size_t)row * DMIX + 1024 + c) = (u32x4){pk_bf16(o[0], o[1]), pk_bf16(o[2], o[3]), pk_bf16(o[4], o[5]), pk_bf16(o[6], o[7])};
    }
}
template <int MODE> __device__ __forceinline__ void compress_unit(const Args& a, Frame& F, int kv, int tl) {
    LAS unsigned char* L = F.lds;
    constexpr int PITCH = 72, STG = 128 * PITCH * 2;
    const int tid = F.tid, lane = F.lane, w = F.wave, r16 = lane & 15, kq = lane >> 4;
    const int R = tid >> 2, c4 = tid & 3;
    const float* srcf = nullptr; const bf16_t* srcb = nullptr;
    if (MODE == 0) { const int sb = tl >> 2, blk = (tl & 3) * 64 + (R >> 1), g = R & 1; const int page = a.page_table[sb * 128 + (blk >> 1)];
        srcf = (kv ? a.cache_v_cmp : a.cache_k_cmp) + (((size_t)page * 128 + (blk & 1) * 64) * 2 + g) * 64 + c4 * 16; }
    else { const int GR = tl * 128 + R, bblk = GR >> 1, g = GR & 1, b = bblk >> 7, blk = bblk & 127;
        srcb = (const bf16_t*)(a.ws + (kv ? WS_VC : WS_KC)) + ((size_t)(b * SEQ + blk * 64)) * 128 + g * 64 + c4 * 16; }
    const bf16_t* wsrc = (const bf16_t*)(a.ws + WS_W1T) + (size_t)kv * 128 * 4096 + (size_t)R * 4096 + c4 * 16;
    const int wm = w >> 1, wn = w & 1;
    f32x4 acc[2][4];
#pragma unroll
    for (int i = 0; i < 2; ++i)
#pragma unroll
        for (int j = 0; j < 4; ++j) acc[i][j] = (f32x4){0.f, 0.f, 0.f, 0.f};
    u32x4 ra[2], rb[2];
    const float* pe = (kv ? a.cmp_pe_v : a.cmp_pe_k) + c4 * 16;
    auto load = [&](int ks) {
        const f32x4* pp = (const f32x4*)(pe + ks * 64); const f32x4 e0 = pp[0], e1 = pp[1], e2 = pp[2], e3 = pp[3];
        f32x4 v0, v1, v2, v3;
        if (MODE == 0) { const f32x4* p = (const f32x4*)(srcf + (size_t)ks * 128); v0 = p[0]; v1 = p[1]; v2 = p[2]; v3 = p[3]; }
        else { const u32x4* p = (const u32x4*)(srcb + (size_t)ks * 128); const u32x4 w0 = p[0], w1 = p[1];
            v0 = (f32x4){bflo(w0.x), bfhi(w0.x), bflo(w0.y), bfhi(w0.y)}; v1 = (f32x4){bflo(w0.z), bfhi(w0.z), bflo(w0.w), bfhi(w0.w)};
            v2 = (f32x4){bflo(w1.x), bfhi(w1.x), bflo(w1.y), bfhi(w1.y)}; v3 = (f32x4){bflo(w1.z), bfhi(w1.z), bflo(w1.w), bfhi(w1.w)}; }
        v0 = v0 + e0; v1 = v1 + e1; v2 = v2 + e2; v3 = v3 + e3;
        ra[0] = (u32x4){pk_bf16(v0.x, v0.y), pk_bf16(v0.z, v0.w), pk_bf16(v1.x, v1.y), pk_bf16(v1.z, v1.w)};
        ra[1] = (u32x4){pk_bf16(v2.x, v2.y), pk_bf16(v2.z, v2.w), pk_bf16(v3.x, v3.y), pk_bf16(v3.z, v3.w)};
        const u32x4* q = (const u32x4*)(wsrc + ks * 64); rb[0] = q[0]; rb[1] = q[1];
    };
    auto store = [&](int st) {
        LAS unsigned char* pa = L + st * STG + (R * PITCH + c4 * 16) * 2; LAS unsigned char* pb = L + 2 * STG + st * STG + (R * PITCH + c4 * 16) * 2;
        *(LAS u32x4*)pa = ra[0]; *(LAS u32x4*)(pa + 16) = ra[1]; *(LAS u32x4*)pb = rb[0]; *(LAS u32x4*)(pb + 16) = rb[1];
    };
    load(0); store(0); __syncthreads();
    for (int ks = 0; ks < 64; ++ks) {
        const int st = ks & 1;
        if (ks + 1 < 64) load(ks + 1);
        LAS const unsigned char* As = L + st * STG; LAS const unsigned char* Bs = L + 2 * STG + st * STG;
#pragma unroll
        for (int s = 0; s < 2; ++s) {
            bf16x8 af[2], bfr[4];
#pragma unroll
            for (int mi = 0; mi < 2; ++mi) af[mi] = *(const LAS bf16x8*)(As + ((32 * wm + 16 * mi + r16) * PITCH + 32 * s + 8 * kq) * 2);
#pragma unroll
            for (int ni = 0; ni < 4; ++ni) bfr[ni] = *(const LAS bf16x8*)(Bs + ((64 * wn + 16 * ni + r16) * PITCH + 32 * s + 8 * kq) * 2);
#pragma unroll
            for (int mi = 0; mi < 2; ++mi)
#pragma unroll
                for (int ni = 0; ni < 4; ++ni) acc[mi][ni] = __builtin_amdgcn_mfma_f32_16x16x32_bf16(af[mi], bfr[ni], acc[mi][ni], 0, 0, 0);
        }
        if (ks + 1 < 64) store(st ^ 1);
        __syncthreads();
    }
    LAS float* HID = (LAS float*)L; LAS float* W2s = (LAS float*)(L + 67584);
#pragma unroll
    for (int mi = 0; mi < 2; ++mi)
#pragma unroll
        for (int ni = 0; ni < 4; ++ni) { const int col = 64 * wn + 16 * ni + r16;
#pragma unroll
            for (int r = 0; r < 4; ++r) HID[(32 * wm + 16 * mi + 4 * kq + r) * 132 + col] = siluf_(acc[mi][ni][r]); }
    { const f32x4* w2 = (const f32x4*)(kv ? a.cmp_w2_v : a.cmp_w2_k);
#pragma unroll
      for (int i = 0; i < 4; ++i) ((LAS f32x4*)W2s)[tid + 512 * i] = w2[tid + 512 * i]; }
    __syncthreads();
    {
        float o[16];
#pragma unroll
        for (int j = 0; j < 16; ++j) o[j] = 0.f;
        for (int n = 0; n < 128; ++n) { const float h = HID[R * 132 + n]; const LAS f32x4* wr = (const LAS f32x4*)(W2s + n * 64 + c4 * 16);
#pragma unroll
            for (int q = 0; q < 4; ++q) { const f32x4 wv = wr[q]; o[4 * q] += h * wv.x; o[4 * q + 1] += h * wv.y; o[4 * q + 2] += h * wv.z; o[4 * q + 3] += h * wv.w; } }
        if (MODE == 0) { const int sb = tl >> 2, blk = (tl & 3) * 64 + (R >> 1), g = R & 1;
            float* d = (float*)(a.ws + (kv ? WS_VCMPS : WS_KCMPS)) + ((size_t)(sb * 2 + g) * 256 + blk) * 64 + c4 * 16;
#pragma unroll
            for (int q = 0; q < 4; ++q) *(f32x4*)(d + 4 * q) = (f32x4){o[4 * q], o[4 * q + 1], o[4 * q + 2], o[4 * q + 3]}; }
        else { const int GR = tl * 128 + R, bblk = GR >> 1, g = GR & 1, b = bblk >> 7, blk = bblk & 127;
            if (kv == 0) { bf16_t* d = (bf16_t*)(a.ws + WS_KCMPP) + ((size_t)(b * 2 + g) * 128 + blk) * 64 + c4 * 16;
                *(u32x4*)d = (u32x4){pk_bf16(o[0], o[1]), pk_bf16(o[2], o[3]), pk_bf16(o[4], o[5]), pk_bf16(o[6], o[7])};
                *(u32x4*)(d + 8) = (u32x4){pk_bf16(o[8], o[9]), pk_bf16(o[10], o[11]), pk_bf16(o[12], o[13]), pk_bf16(o[14], o[15])}; }
            else { bf16_t* d = (bf16_t*)(a.ws + WS_VCMPT) + ((size_t)(b * 2 + g) * 64 + c4 * 16) * 128 + (blk & ~31) + vslot32(blk & 31);
#pragma unroll
                for (int j = 0; j < 16; ++j) d[(size_t)j * 128] = (bf16_t)(pk_bf16(o[j], 0.f) & 0xffffu); } }
    }
    __syncthreads();
}

__device__ __forceinline__ int swz_off(int row, int chunk) { return row * 128 + ((chunk ^ (row & 7)) << 4); }
constexpr int NST = 4, STB = 16384;
__device__ __forceinline__ void tile_dma(const bf16_t* Kbg, const bf16_t* Vtbg, int j, LAS unsigned char* stage, int w, int lane) {
    const int c = w * 64 + lane, row = c >> 3, sc = (c & 7) ^ (row & 7);
    __builtin_amdgcn_global_load_lds((const unsigned*)(Kbg + (size_t)(64 * j + row) * 128 + sc * 8), (LAS unsigned*)(stage + w * 1024), 16, 0, 0);
    __builtin_amdgcn_global_load_lds((const unsigned*)(Vtbg + (size_t)j * 4096 + row * 64 + sc * 8), (LAS unsigned*)(stage + 8192 + w * 1024), 16, 0, 0);
}
__device__ __forceinline__ void tile_wait(int ahead) {
    if (ahead >= 2) asm volatile("s_waitcnt vmcnt(4)" ::: "memory"); else if (ahead == 1) asm volatile("s_waitcnt vmcnt(2)" ::: "memory"); else asm volatile("s_waitcnt vmcnt(0)" ::: "memory");
}
__device__ __forceinline__ void build_xt(const Args& a, Frame& F, int off, int DMAX, int NE, int DLIM, int g) {
    const float* BT = (const float*)(a.ws + WS_BT); LAS float* d = (LAS float*)(F.lds + off);
    for (int i = F.tid; i < NE * 8; i += 512) { const int dd = DMAX - (i >> 3); d[i] = (dd < 0 || dd > DLIM) ? NEG_INF : BT[(dd > 128 ? 128 : dd) * 16 + g * 8 + (i & 7)]; }
}
constexpr float LAZY_THR = 20.f;
template <int DMAX, bool COLSEL>
__device__ __forceinline__ void pair_tile(f32x4 (&O)[4], float& mrun, float& lrun, const bf16x8 (&Qf)[2], LAS const unsigned char* Kt, LAS const unsigned char* Vt,
                                          LAS const float* XT, int r16, int kq, bool colsel, int dbase, int hh) {
    const int dbc = dbase < DMAX ? dbase : DMAX;
    LAS const float* bp = XT + (4 * kq - dbc + DMAX) * 8 + (hh & 7);
    bf16x8 kf[4][2], vf[4][2]; f32x4 bs[4];
#pragma unroll
    for (int m = 0; m < 4; ++m)
#pragma unroll
        for (int s = 0; s < 2; ++s) kf[m][s] = *(const LAS bf16x8*)(Kt + swz_off(16 * m + r16, 4 * s + kq));
#pragma unroll
    for (int m = 0; m < 4; ++m)
#pragma unroll
        for (int r = 0; r < 4; ++r) bs[m][r] = bp[(16 * m + r) * 8];
    asm volatile("" ::: "memory");
    f32x4 S[4];
#pragma unroll
    for (int m = 0; m < 4; ++m) { S[m] = __builtin_amdgcn_mfma_f32_16x16x32_bf16(kf[m][0], Qf[0], bs[m], 0, 0, 0); S[m] = __builtin_amdgcn_mfma_f32_16x16x32_bf16(kf[m][1], Qf[1], S[m], 0, 0, 0); }
#pragma unroll
    for (int md = 0; md < 4; ++md)
#pragma unroll
        for (int s = 0; s < 2; ++s) vf[md][s] = *(const LAS bf16x8*)(Vt + swz_off(16 * md + r16, 4 * s + kq));
    asm volatile("" ::: "memory");
    float mx4[4];
#pragma unroll
    for (int m = 0; m < 4; ++m) mx4[m] = fmaxf(fmaxf(S[m][0], S[m][1]), fmaxf(S[m][2], S[m][3]));
    float mx = fmaxf(fmaxf(mx4[0], mx4[1]), fmaxf(mx4[2], mx4[3]));
    if (COLSEL && !colsel) mx = NEG_INF;
    if (__any(mx > mrun + LAZY_THR || (lrun == 0.f && mx < mrun - LAZY_THR && mx != NEG_INF))) {
        mx = xmax_16_32(mx);
        const bool first = xmax_16_32(lrun) == 0.f;
        const float mnew = first ? ((mx == NEG_INF) ? mrun : mx) : fmaxf(mrun, mx);
        const float alpha = first ? 1.f : fexp2(mrun - mnew);
        lrun *= alpha; mrun = mnew;
#pragma unroll
        for (int md = 0; md < 4; ++md) O[md] = O[md] * alpha;
    }
    if (__any(mrun != 0.f)) {
#pragma unroll
        for (int m = 0; m < 4; ++m) S[m] = S[m] - mrun; }
    float ps4[4];
#pragma unroll
    for (int m = 0; m < 4; ++m) {
#pragma unroll
        for (int r = 0; r < 4; ++r) S[m][r] = fexp2(S[m][r]);
        if (COLSEL && !colsel) S[m] = (f32x4){0.f, 0.f, 0.f, 0.f};
        ps4[m] = (S[m][0] + S[m][1]) + (S[m][2] + S[m][3]); }
    lrun += (ps4[0] + ps4[1]) + (ps4[2] + ps4[3]);
    bf16x8 Pf[2];
#pragma unroll
    for (int s = 0; s < 2; ++s) { const u32x4 w = (u32x4){pk_bf16(S[2 * s][0], S[2 * s][1]), pk_bf16(S[2 * s][2], S[2 * s][3]), pk_bf16(S[2 * s + 1][0], S[2 * s + 1][1]), pk_bf16(S[2 * s + 1][2], S[2 * s + 1][3])};
        Pf[s] = __builtin_bit_cast(bf16x8, w); }
#pragma unroll
    for (int md = 0; md < 4; ++md) { O[md] = __builtin_amdgcn_mfma_f32_16x16x32_bf16(vf[md][0], Pf[0], O[md], 0, 0, 0); O[md] = __builtin_amdgcn_mfma_f32_16x16x32_bf16(vf[md][1], Pf[1], O[md], 0, 0, 0); }
}

template <int DMAX>
__device__ __forceinline__ void quad_tile(f32x4 (&O)[4][4], float (&mrun)[4], float (&lrun)[4], LAS const bf16x8* QL, LAS const unsigned char* Kt, LAS const unsigned char* Vt,
                                          LAS const float* XT, int r16, int kq, int dbase0, int hh) {
    bf16x8 Pf[4][2];
    bf16x8 kf[4][2], vf[4][2];
    LAS const float* bp3 = XT + (4 * kq - dbase0 - 6 + DMAX) * 8 + (hh & 7);
#pragma unroll
    for (int m = 0; m < 4; ++m)
#pragma unroll
        for (int s = 0; s < 2; ++s) kf[m][s] = *(const LAS bf16x8*)(Kt + swz_off(16 * m + r16, 4 * s + kq));
    f32x4 bs[2][4]; bf16x8 qn[2][2];
#pragma unroll
    for (int m = 0; m < 4; ++m)
#pragma unroll
        for (int r = 0; r < 4; ++r) bs[0][m][r] = bp3[(16 * m + r + 6) * 8];
    qn[0][0] = QL[0]; qn[0][1] = QL[64];
    asm volatile("" ::: "memory");
#pragma unroll
    for (int p = 0; p < 4; ++p) {
        if (p < 3) {
#pragma unroll
            for (int m = 0; m < 4; ++m)
#pragma unroll
                for (int r = 0; r < 4; ++r) bs[(p + 1) & 1][m][r] = bp3[(16 * m + r + 6 - 2 * (p + 1)) * 8];
            qn[(p + 1) & 1][0] = QL[((p + 1) * 2) * 64]; qn[(p + 1) & 1][1] = QL[((p + 1) * 2 + 1) * 64];
        }
        asm volatile("" ::: "memory");
        f32x4 S[4];
#pragma unroll
        for (int m = 0; m < 4; ++m) { S[m] = __builtin_amdgcn_mfma_f32_16x16x32_bf16(kf[m][0], qn[p & 1][0], bs[p & 1][m], 0, 0, 0); S[m] = __builtin_amdgcn_mfma_f32_16x16x32_bf16(kf[m][1], qn[p & 1][1], S[m], 0, 0, 0); }
        float mx4[4];
#pragma unroll
        for (int m = 0; m < 4; ++m) mx4[m] = fmaxf(fmaxf(S[m][0], S[m][1]), fmaxf(S[m][2], S[m][3]));
        float mx = fmaxf(fmaxf(mx4[0], mx4[1]), fmaxf(mx4[2], mx4[3]));
        if (__any(mx > mrun[p] + LAZY_THR || (lrun[p] == 0.f && mx < mrun[p] - LAZY_THR && mx != NEG_INF))) {
            mx = xmax_16_32(mx);
            const bool first = xmax_16_32(lrun[p]) == 0.f;
            const float mnew = first ? ((mx == NEG_INF) ? mrun[p] : mx) : fmaxf(mrun[p], mx);
            const float alpha = first ? 1.f : fexp2(mrun[p] - mnew);
            lrun[p] *= alpha; mrun[p] = mnew;
#pragma unroll
            for (int md = 0; md < 4; ++md) O[p][md] = O[p][md] * alpha;
        }
        if (__any(mrun[p] != 0.f)) {
#pragma unroll
            for (int m = 0; m < 4; ++m) S[m] = S[m] - mrun[p]; }
        float ps4[4];
#pragma unroll
        for (int m = 0; m < 4; ++m) {
#pragma unroll
            for (int r = 0; r < 4; ++r) S[m][r] = fexp2(S[m][r]);
            ps4[m] = (S[m][0] + S[m][1]) + (S[m][2] + S[m][3]); }
        lrun[p] += (ps4[0] + ps4[1]) + (ps4[2] + ps4[3]);
#pragma unroll
        for (int s = 0; s < 2; ++s) { const u32x4 w = (u32x4){pk_bf16(S[2 * s][0], S[2 * s][1]), pk_bf16(S[2 * s][2], S[2 * s][3]), pk_bf16(S[2 * s + 1][0], S[2 * s + 1][1]), pk_bf16(S[2 * s + 1][2], S[2 * s + 1][3])};
            Pf[p][s] = __builtin_bit_cast(bf16x8, w); }
    }
#pragma unroll
    for (int md = 0; md < 4; ++md)
#pragma unroll
        for (int s = 0; s < 2; ++s) vf[md][s] = *(const LAS bf16x8*)(Vt + swz_off(16 * md + r16, 4 * s + kq));
#pragma unroll
    for (int p = 0; p < 4; ++p)
#pragma unroll
        for (int md = 0; md < 4; ++md) { O[p][md] = __builtin_amdgcn_mfma_f32_16x16x32_bf16(vf[md][0], Pf[p][0], O[p][md], 0, 0, 0); O[p][md] = __builtin_amdgcn_mfma_f32_16x16x32_bf16(vf[md][1], Pf[p][1], O[p][md], 0, 0, 0); }
}

constexpr int AT_RING = 0;
constexpr int AT_KCMP = 65536;
constexpr int AT_VCMP = 81920;
constexpr int AT_SCORE = 98304;
constexpr int AT_XT = 131072;
constexpr int WIN_XT = 65536;
constexpr int WIN_QL = 65536 + 20480;
constexpr int SEL_DMAX = 255, SEL_NE = 319, WIN_DMAX = 575, WIN_NE = 639;
static_assert(AT_XT + SEL_NE * 32 <= LDS_CTL && WIN_XT + WIN_NE * 32 <= WIN_QL && WIN_QL + 65536 <= LDS_CTL, "attention LDS map");

__device__ __forceinline__ void win_unit(const Args& a, Frame& F, int b, int g, int qb) {
    LAS unsigned char* L = F.lds; const int lane = F.lane, w = F.wave, r16 = lane & 15, kq = lane >> 4, slot = r16 >> 3, h = r16 & 7, hh = g * 8 + h;
    const bf16_t* Kbg = (const bf16_t*)(a.ws + WS_KW) + (size_t)b * SEQ * 128 + g * 64;
    const bf16_t* Vtbg = (const bf16_t*)(a.ws + WS_VWT) + (size_t)(b * 2 + g) * 128 * 4096;
    const bf16_t* Qb = (const bf16_t*)(a.ws + WS_Q);
    LAS const float* XT = (LAS const float*)(L + WIN_XT);
    const int j0 = qb >= 8 ? qb - 8 : 0;
#pragma nounroll
    for (int t = 0; t < 3; ++t) if (j0 + t <= qb) tile_dma(Kbg, Vtbg, j0 + t, L + AT_RING + t * STB, w, lane);
    build_xt(a, F, WIN_XT, WIN_DMAX, WIN_NE, 512, g);
    LAS bf16x8* QL = (LAS bf16x8*)(L + WIN_QL + w * 8192) + lane;
#pragma unroll
    for (int p = 0; p < 4; ++p) { const int q = qb * 64 + w * 8 + 2 * p + slot; const bf16_t* qp = Qb + ((size_t)(b * SEQ + q)) * DM + g * 512 + h * 64 + 8 * kq;
        QL[(p * 2) * 64] = *(const bf16x8*)qp; QL[(p * 2 + 1) * 64] = *(const bf16x8*)(qp + 32); }
    f32x4 O[4][4]; float mr[4], lr[4];
#pragma unroll
    for (int p = 0; p < 4; ++p) { mr[p] = 0.f; lr[p] = 0.f;
#pragma unroll
        for (int md = 0; md < 4; ++md) O[p][md] = (f32x4){0.f, 0.f, 0.f, 0.f}; }
    asm volatile("s_waitcnt vmcnt(0) lgkmcnt(0)" ::: "memory");
    for (int j = j0; j <= qb; ++j) {
        tile_wait((qb - j) < 2 ? (qb - j) : 2);
        asm volatile("s_waitcnt lgkmcnt(0)" ::: "memory"); __builtin_amdgcn_s_barrier(); asm volatile("" ::: "memory");
        if (j + 3 <= qb) tile_dma(Kbg, Vtbg, j + 3, L + AT_RING + ((j - j0 + 3) % NST) * STB, w, lane);
        LAS const unsigned char* Kt = L + AT_RING + ((j - j0) % NST) * STB; LAS const unsigned char* Vt = Kt + 8192;
        quad_tile<WIN_DMAX>(O, mr, lr, QL, Kt, Vt, XT, r16, kq, 64 * (qb - j) + w * 8 + slot, hh);
    }
    bf16_t* OW = (bf16_t*)(a.ws + WS_OWIN);
#pragma unroll
    for (int p = 0; p < 4; ++p) { const float lt = xsum_16_32(lr[p]); const float inv = lt > 0.f ? 1.f / lt : 0.f;
        const int q = qb * 64 + w * 8 + 2 * p + slot; bf16_t* d = OW + ((size_t)(b * SEQ + q)) * DM + g * 512 + h * 64 + 4 * kq;
#pragma unroll
        for (int md = 0; md < 4; ++md) { const f32x4 o = O[p][md] * inv; *(u32x2*)(d + 16 * md) = (u32x2){pk_bf16(o.x, o.y), pk_bf16(o.z, o.w)}; } }
    __syncthreads();
}

template <int NE, int NQ> __device__ __forceinline__ void topk16(const unsigned (&key)[NQ][NE], unsigned long long (&sel)[NQ][NE], int lane) {
    unsigned T[NQ];
#pragma unroll
    for (int q = 0; q < NQ; ++q) T[q] = 0u;
    for (int bit = 31; bit >= 0; --bit) {
#pragma unroll
        for (int q = 0; q < NQ; ++q) { const unsigned cand = T[q] | (1u << bit); int cnt = 0;
#pragma unroll
            for (int e = 0; e < NE; ++e) cnt += __popcll(__ballot(key[q][e] >= cand));
            if (cnt >= 16) T[q] = cand; } }
    const unsigned long long lt = (1ull << lane) - 1ull;
#pragma unroll
    for (int q = 0; q < NQ; ++q) {
        if (T[q] == 0u) {
#pragma unroll
            for (int e = 0; e < NE; ++e) sel[q][e] = __ballot(key[q][e] > 0u);
        } else {
            int ngt = 0;
#pragma unroll
            for (int e = 0; e < NE; ++e) ngt += __popcll(__ballot(key[q][e] > T[q]));
            const int need = 16 - ngt; int prior = 0;
#pragma unroll
            for (int e = 0; e < NE; ++e) { const bool eq = key[q][e] == T[q]; const unsigned long long em = __ballot(eq); const int rank = prior + __popcll(em & lt);
                sel[q][e] = __ballot(key[q][e] > T[q] || (eq && rank < need)); prior += __popcll(em); }
        }
    }
}

__device__ __forceinline__ void nsa_unit(const Args& a, Frame& F, int b, int g, int qb) {
    LAS unsigned char* L = F.lds; const int tid = F.tid, lane = F.lane, w = F.wave, r16 = lane & 15, kq = lane >> 4, slot = r16 >> 3, h = r16 & 7, hh = g * 8 + h;
    const bf16_t* Kbg = (const bf16_t*)(a.ws + WS_KSL) + (size_t)b * SEQ * 128 + g * 64;
    const bf16_t* Vtbg = (const bf16_t*)(a.ws + WS_VSLT) + (size_t)(b * 2 + g) * 128 * 4096;
    const bf16_t* Qb = (const bf16_t*)(a.ws + WS_Q);
    LAS const float* XT = (LAS const float*)(L + AT_XT);
    LAS float* SCORE = (LAS float*)(L + AT_SCORE);
#pragma nounroll
    for (int t = 0; t < 3; ++t) if (t <= qb) tile_dma(Kbg, Vtbg, t, L + AT_RING + t * STB, w, lane);
    { const u32x4* ks = (const u32x4*)((const bf16_t*)(a.ws + WS_KCMPP) + (size_t)(b * 2 + g) * 128 * 64);
      const u32x4* vs = (const u32x4*)((const bf16_t*)(a.ws + WS_VCMPT) + (size_t)(b * 2 + g) * 64 * 128);
#pragma unroll
      for (int i = 0; i < 2; ++i) { const int c = tid + 512 * i;
          *(LAS u32x4*)(L + AT_KCMP + swz_off(c >> 3, c & 7)) = ks[c];
          const int row = c >> 4, ch = c & 15; *(LAS u32x4*)(L + AT_VCMP + row * 256 + (((ch & 8) | ((ch ^ row) & 7)) << 4)) = vs[c]; } }
    build_xt(a, F, AT_XT, SEL_DMAX, SEL_NE, 1 << 30, g);
    bf16x8 Qf[4][2];
#pragma unroll
    for (int p = 0; p < 4; ++p) { const int q = qb * 64 + w * 8 + 2 * p + slot; const bf16_t* qp = Qb + ((size_t)(b * SEQ + q)) * DM + g * 512 + h * 64 + 8 * kq;
        Qf[p][0] = *(const bf16x8*)qp; Qf[p][1] = *(const bf16x8*)(qp + 32); }
    __syncthreads();
    const float* Gt = (const float*)(a.ws + WS_G);
    bf16_t* A2 = (bf16_t*)(a.ws + WS_A2);
    const int nmt = (qb + 16) >> 4;
#pragma unroll
    for (int p = 0; p < 4; ++p) {
        const int i = w * 8 + 2 * p + slot, q = qb * 64 + i;
        f32x4 S[8]; float mx = NEG_INF;
#pragma unroll
        for (int m = 0; m < 8; ++m) { S[m] = (f32x4){NEG_INF, NEG_INF, NEG_INF, NEG_INF};
            if (m < nmt) { f32x4 c = (f32x4){0.f, 0.f, 0.f, 0.f};
#pragma unroll
                for (int s = 0; s < 2; ++s) { const bf16x8 kf = *(const LAS bf16x8*)(L + AT_KCMP + swz_off(16 * m + r16, 4 * s + kq)); c = __builtin_amdgcn_mfma_f32_16x16x32_bf16(kf, Qf[p][s], c, 0, 0, 0); }
#pragma unroll
                for (int r = 0; r < 4; ++r) { const int jb = 16 * m + 4 * kq + r; const bool vis = (jb < qb) || (jb == qb && i == 63);
                    int d = 64 * (qb - jb) + i - 63; d = d < 0 ? 0 : (d > 128 ? 128 : d);
                    const float v = vis ? c[r] + XT[(SEL_DMAX - d) * 8 + h] : NEG_INF; S[m][r] = v; mx = fmaxf(mx, v); } } }
        mx = xmax_16_32(mx);
        const float msafe = (mx == NEG_INF) ? 0.f : mx; float ps = 0.f;
#pragma unroll
        for (int m = 0; m < 8; ++m)
#pragma unroll
            for (int r = 0; r < 4; ++r) { const float pp = fexp2(S[m][r] - msafe); S[m][r] = pp; ps += pp; }
        ps = xsum_16_32(ps);
        const float inv = ps > 0.f ? 1.f / ps : 0.f;
#pragma unroll
        for (int m = 0; m < 8; ++m) { f32x4 pn = S[m] * inv; S[m] = pn;
            f32x4 im = pn;
#pragma unroll
            for (int r = 0; r < 4; ++r) im[r] = dpp_sum8(im[r]);
#pragma unroll
            for (int r = 0; r < 4; ++r) { const int jb = 16 * m + 4 * kq + r; const bool vis = (jb < qb) || (jb == qb && i == 63);
                im[r] = vis ? im[r] : (jb <= qb ? 2.0f : -1.0f); }
            if (h == 0) *(LAS f32x4*)(SCORE + i * 128 + 16 * m + 4 * kq) = im; }
        f32x4 oc[4];
#pragma unroll
        for (int md = 0; md < 4; ++md) oc[md] = (f32x4){0.f, 0.f, 0.f, 0.f};
#pragma unroll
        for (int s = 0; s < 4; ++s) if (2 * s < nmt) {
            const u32x4 wv = (u32x4){pk_bf16(S[2 * s][0], S[2 * s][1]), pk_bf16(S[2 * s][2], S[2 * s][3]), pk_bf16(S[2 * s + 1][0], S[2 * s + 1][1]), pk_bf16(S[2 * s + 1][2], S[2 * s + 1][3])};
            const bf16x8 pf = __builtin_bit_cast(bf16x8, wv);
#pragma unroll
            for (int md = 0; md < 4; ++md) { const int row = 16 * md + r16, ch = 4 * s + kq;
                const bf16x8 vf = *(const LAS bf16x8*)(L + AT_VCMP + row * 256 + (((ch & 8) | ((ch ^ row) & 7)) << 4));
                oc[md] = __builtin_amdgcn_mfma_f32_16x16x32_bf16(vf, pf, oc[md], 0, 0, 0); } }
        const float g0 = Gt[(size_t)(b * SEQ + q) * 48 + hh];
#pragma unroll
        for (int md = 0; md < 4; ++md) { const f32x4 o = oc[md] * g0;
            *(u32x2*)(A2 + (size_t)(b * SEQ + q) * DMIX + g * 512 + h * 64 + 4 * kq + 16 * md) = (u32x2){pk_bf16(o.x, o.y), pk_bf16(o.z, o.w)}; }
    }
    LDS_WAIT(); __builtin_amdgcn_wave_barrier(); asm volatile("" ::: "memory");
    unsigned long long mA[8], mB[8];
#pragma unroll
    for (int qh = 0; qh < 2; ++qh) { unsigned key[4][2]; unsigned long long sel[4][2];
#pragma unroll
        for (int qq = 0; qq < 4; ++qq) { const int i = w * 8 + 4 * qh + qq; const float sa = SCORE[i * 128 + lane], sb = SCORE[i * 128 + 64 + lane];
            key[qq][0] = sa >= 0.f ? __float_as_uint(sa) + 1u : 0u; key[qq][1] = sb >= 0.f ? __float_as_uint(sb) + 1u : 0u; }
        topk16<2, 4>(key, sel, lane);
#pragma unroll
        for (int qq = 0; qq < 4; ++qq) { mA[4 * qh + qq] = sel[qq][0]; mB[4 * qh + qq] = sel[qq][1]; } }
    __syncthreads();
    LAS bf16x8* QL = (LAS bf16x8*)(L + AT_KCMP + w * 8192) + lane;
#pragma unroll
    for (int p = 0; p < 4; ++p) { QL[(p * 2) * 64] = Qf[p][0]; QL[(p * 2 + 1) * 64] = Qf[p][1]; }
    LDS_WAIT(); asm volatile("" ::: "memory");
    f32x4 O[4][4]; float mr[4], lr[4];
#pragma unroll
    for (int p = 0; p < 4; ++p) { mr[p] = 0.f; lr[p] = 0.f;
#pragma unroll
        for (int md = 0; md < 4; ++md) O[p][md] = (f32x4){0.f, 0.f, 0.f, 0.f}; }
    asm volatile("s_waitcnt vmcnt(0)" ::: "memory");
    for (int j = 0; j <= qb; ++j) {
        if (j >= 3) tile_wait((qb - j) < 2 ? (qb - j) : 2);
        asm volatile("s_waitcnt lgkmcnt(0)" ::: "memory"); __builtin_amdgcn_s_barrier(); asm volatile("" ::: "memory");
        if (j + 3 <= qb) tile_dma(Kbg, Vtbg, j + 3, L + AT_RING + ((j + 3) % NST) * STB, w, lane);
        LAS const unsigned char* Kt = L + AT_RING + (j % NST) * STB; LAS const unsigned char* Vt = Kt + 8192;
#pragma unroll
        for (int p = 0; p < 4; ++p) {
            const bool a0 = (((j < 64 ? mA[2 * p] : mB[2 * p]) >> (j & 63)) & 1ull) != 0ull, a1 = (((j < 64 ? mA[2 * p + 1] : mB[2 * p + 1]) >> (j & 63)) & 1ull) != 0ull;
            if (a0 || a1) { const int i = w * 8 + 2 * p + slot; bf16x8 qf[2]; qf[0] = QL[(p * 2) * 64]; qf[1] = QL[(p * 2 + 1) * 64];
                pair_tile<SEL_DMAX, true>(O[p], mr[p], lr[p], qf, Kt, Vt, XT, r16, kq, slot ? a1 : a0, 64 * (qb - j) + i, hh); } }
    }
    const bf16_t* OW = (const bf16_t*)(a.ws + WS_OWIN); const bf16_t* SZ = (const bf16_t*)(a.ws + WS_SZA);
#pragma unroll
    for (int p = 0; p < 4; ++p) { const float lt = xsum_16_32(lr[p]);
        const int q = qb * 64 + w * 8 + 2 * p + slot; const size_t row = (size_t)(b * SEQ + q);
        const float g1 = Gt[row * 48 + 16 + hh], g2 = Gt[row * 48 + 32 + hh]; const float inv = lt > 0.f ? g1 / lt : 0.f;
        const int col = g * 512 + h * 64 + 4 * kq;
#pragma unroll
        for (int md = 0; md < 4; ++md) { const u32x2 ow = *(const u32x2*)(OW + row * DM + col + 16 * md), sz = *(const u32x2*)(SZ + row * DM + col + 16 * md);
            const u32x2 ocv = __builtin_nontemporal_load((const u32x2*)(A2 + row * DMIX + col + 16 * md));
            const f32x4 o = (f32x4){bflo(ocv.x), bfhi(ocv.x), bflo(ocv.y), bfhi(ocv.y)} + O[p][md] * inv + (f32x4){bflo(ow.x), bfhi(ow.x), bflo(ow.y), bfhi(ow.y)} * g2;
            const f32x4 r = o * (f32x4){bflo(sz.x), bfhi(sz.x), bflo(sz.y), bfhi(sz.y)};
            *(u32x2*)(A2 + row * DMIX + col + 16 * md) = (u32x2){pk_bf16(r.x, r.y), pk_bf16(r.z, r.w)}; }
        asm volatile("" ::: "memory"); }
    __syncthreads();
}

constexpr int SU_KT = 0, SU_VT = 17408, SU_QS = 34816, SU_PW = 36864, SU_IMP = 38912, SU_BT = 47360, SU_SEL = 55616, SU_SCORE = 55808;
struct VSrc { const float* k; const float* v; bool ok; };
__device__ __forceinline__ float valu_tile(LAS const float* KT, LAS const float* VT, LAS const float* QSh, LAS float* PWh, int lane, bool ok, float bias, float& m, float& l, float& O) {
    float s = 0.f;
#pragma unroll 4
    for (int d4 = 0; d4 < 16; ++d4) { const f32x4 kk = *(const LAS f32x4*)(KT + lane * 68 + 4 * d4), qq = *(const LAS f32x4*)(QSh + 4 * d4); s += kk.x * qq.x + kk.y * qq.y + kk.z * qq.z + kk.w * qq.w; }
    s = ok ? s + bias : NEG_INF;
    const float mt = wave_max(s), mnew = fmaxf(m, mt), msafe = (mnew == NEG_INF) ? 0.f : mnew;
    const float alpha = fexp2(m - msafe), p = fexp2(s - msafe);
    l = l * alpha + wave_sum(p); m = mnew;
    PWh[lane] = p; LDS_WAIT(); __builtin_amdgcn_wave_barrier();
    float o = O * alpha;
#pragma unroll 4
    for (int k4 = 0; k4 < 16; ++k4) { const f32x4 pp = *(const LAS f32x4*)(PWh + 4 * k4);
        o += pp.x * VT[(4 * k4) * 68 + lane] + pp.y * VT[(4 * k4 + 1) * 68 + lane] + pp.z * VT[(4 * k4 + 2) * 68 + lane] + pp.w * VT[(4 * k4 + 3) * 68 + lane]; }
    O = o; LDS_WAIT(); __builtin_amdgcn_wave_barrier();
    return s;
}
struct VRegs { f32x4 k0, k1, v0, v1; };
__device__ __forceinline__ void vfetch(VRegs& r, const VSrc& s) {
    if (s.ok) { const f32x4* kp = (const f32x4*)s.k; const f32x4* vp = (const f32x4*)s.v; r.k0 = kp[0]; r.k1 = kp[1]; r.v0 = vp[0]; r.v1 = vp[1]; }
    else { r.k0 = r.k1 = r.v0 = r.v1 = (f32x4){0.f, 0.f, 0.f, 0.f}; }
}
__device__ __forceinline__ void vstore(const VRegs& r, LAS unsigned char* L, int tid) {
    LAS float* kd = (LAS float*)(L + SU_KT) + (tid >> 3) * 68 + (tid & 7) * 8; LAS float* vd = (LAS float*)(L + SU_VT) + (tid >> 3) * 68 + (tid & 7) * 8;
    *(LAS f32x4*)kd = r.k0; *(LAS f32x4*)(kd + 4) = r.k1; *(LAS f32x4*)vd = r.v0; *(LAS f32x4*)(vd + 4) = r.v1;
}
__device__ __forceinline__ void load_bt(const Args& a, Frame& F, int off) {
    const float* BT = (const float*)(a.ws + WS_BT); LAS float* d = (LAS float*)(F.lds + off);
    for (int i = F.tid; i < 129 * 16; i += 512) d[i] = BT[i];
}
__device__ __forceinline__ void sample_unit(const Args& a, Frame& F, int sb, int g, int t) {
    LAS unsigned char* L = F.lds; const int tid = F.tid, lane = F.lane, h = F.wave, hh = g * 8 + h, key = tid >> 3, c8 = tid & 7;
    const int qpos = PAST + t; const size_t row = (size_t)NPR + sb * 4 + t;
    LAS float* QSh = (LAS float*)(L + SU_QS) + h * 64; LAS float* PWh = (LAS float*)(L + SU_PW) + h * 64; LAS float* IMP = (LAS float*)(L + SU_IMP);
    LAS const float* BTl = (LAS const float*)(L + SU_BT); LAS int* SEL = (LAS int*)(L + SU_SEL); LAS float* SCORE = (LAS float*)(L + SU_SCORE);
    LAS const float* KT = (LAS const float*)(L + SU_KT); LAS const float* VT = (LAS const float*)(L + SU_VT);
    load_bt(a, F, SU_BT);
    QSh[lane] = bf2f(((const bf16_t*)(a.ws + WS_Q))[row * DM + g * 512 + h * 64 + lane]);
    VRegs vr; VSrc src;
    const float* kc = (const float*)(a.ws + WS_KCMPS) + (size_t)(sb * 2 + g) * 256 * 64; const float* vc = (const float*)(a.ws + WS_VCMPS) + (size_t)(sb * 2 + g) * 256 * 64;
    float mc = NEG_INF, lc = 0.f, oc = 0.f, sc[4];
    src.k = kc + (size_t)key * 64 + c8 * 8; src.v = vc + (size_t)key * 64 + c8 * 8; src.ok = true; vfetch(vr, src);
    __syncthreads();
#pragma unroll
    for (int tl = 0; tl < 4; ++tl) {
        vstore(vr, L, tid); __syncthreads();
        if (tl < 3) { src.k = kc + (size_t)(64 * (tl + 1) + key) * 64 + c8 * 8; src.v = vc + (size_t)(64 * (tl + 1) + key) * 64 + c8 * 8; vfetch(vr, src); }
        int d = qpos - (64 * (64 * tl + lane) + 63); d = d > 128 ? 128 : d;
        sc[tl] = valu_tile(KT, VT, QSh, PWh, lane, true, BTl[d * 16 + hh], mc, lc, oc);
        __syncthreads();
    }
    { const float inv = 1.f / lc;
#pragma unroll
      for (int tl = 0; tl < 4; ++tl) IMP[h * 264 + 64 * tl + lane] = fexp2(sc[tl] - mc) * inv;
      oc *= inv; }
    __syncthreads();
    if (tid < 256) { float s = 0.f;
#pragma unroll
        for (int hq = 0; hq < 8; ++hq) s += IMP[hq * 264 + tid]; SCORE[tid] = s; }
    if (tid == 256) SCORE[256] = 2.0f;
    __syncthreads();
    if (h == 0) {
        unsigned keyv[1][5];
#pragma unroll
        for (int e = 0; e < 4; ++e) { const float s = SCORE[64 * e + lane]; keyv[0][e] = s >= 0.f ? __float_as_uint(s) + 1u : 0u; }
        keyv[0][4] = (lane == 0) ? __float_as_uint(SCORE[256]) + 1u : 0u;
        unsigned long long sel[1][5]; topk16<5, 1>(keyv, sel, lane);
        int base = 0;
#pragma unroll
        for (int e = 0; e < 5; ++e) { const bool on = (sel[0][e] >> lane) & 1ull; const int pos = base + __popcll(sel[0][e] & ((1ull << lane) - 1ull)); if (on && pos < 16) SEL[pos] = 64 * e + lane; base += __popcll(sel[0][e]); }
        if (lane == 0) SEL[16] = base < 16 ? base : 16;
    }
    __syncthreads();
    const int nsel = SEL[16];
    float ms = NEG_INF, ls = 0.f, os = 0.f;
    auto sel_src = [&](int n) { const int idx = SEL[n]; VSrc s;
        if (idx < 256) { const int page = a.page_table[sb * 128 + (idx >> 1)]; const size_t off = (((size_t)page * 128 + (idx & 1) * 64 + key) * 2 + g) * 64 + c8 * 8; s.k = a.cache_k_slc + off; s.v = a.cache_v_slc + off; s.ok = true; }
        else { const size_t off = ((size_t)(sb * 4 + (key & 3)) * 2 + g) * 64 + c8 * 8; s.k = a.out + O_SKC + 2 * SZ_SKV + off; s.v = a.out + O_SKC + 3 * SZ_SKV + off; s.ok = key < 4; }
        return s; };
    if (nsel > 0) { src = sel_src(0); vfetch(vr, src); }
    for (int n = 0; n < nsel; ++n) {
        vstore(vr, L, tid); __syncthreads();
        const int idx = SEL[n];
        if (n + 1 < nsel) { src = sel_src(n + 1); vfetch(vr, src); }
        int d = qpos - (64 * idx + lane); const bool ok = d >= 0; d = d < 0 ? 0 : (d > 128 ? 128 : d);
        (void)valu_tile(KT, VT, QSh, PWh, lane, ok, BTl[d * 16 + hh], ms, ls, os);
        __syncthreads();
    }
    float mw = NEG_INF, lw = 0.f, ow = 0.f;
    auto win_src = [&](int n) { VSrc s;
        if (n < 8) { const size_t off = (((size_t)sb * 512 + 64 * n + key) * 2 + g) * 64 + c8 * 8; s.k = a.cache_k_win + off; s.v = a.cache_v_win + off; s.ok = true; }
        else { const size_t off = (((size_t)sb * 512 + 508 + (key & 3)) * 2 + g) * 64 + c8 * 8; s.k = a.out + O_SKW + off; s.v = a.out + O_SKW + SZ_SW + off; s.ok = key < 4; }
        return s; };
    src = win_src(0); vfetch(vr, src);
    for (int n = 0; n < 9; ++n) {
        vstore(vr, L, tid); __syncthreads();
        if (n + 1 < 9) { src = win_src(n + 1); vfetch(vr, src); }
        int d; bool ok;
        if (n < 8) { const int r = 64 * n + lane; d = 512 + t - r; ok = r >= t; } else { d = t - lane; ok = lane <= t; }
        d = d < 0 ? 0 : (d > 128 ? 128 : d);
        (void)valu_tile(KT, VT, QSh, PWh, lane, ok, BTl[d * 16 + hh], mw, lw, ow);
        __syncthreads();
    }
    const float* Gt = (const float*)(a.ws + WS_G) + row * 48;
    const float o = Gt[hh] * oc + Gt[16 + hh] * (ls > 0.f ? os / ls : 0.f) + Gt[32 + hh] * (lw > 0.f ? ow / lw : 0.f);
    const int col = g * 512 + h * 64 + lane;
    const float sz = bf2f(((const bf16_t*)(a.ws + WS_SZA))[row * DM + col]);
    ((bf16_t*)(a.ws + WS_A2))[row * DMIX + col] = (bf16_t)(pk_bf16(o * sz, 0.f) & 0xffffu);
    __syncthreads();
}

constexpr int NPHASE = 7;
__global__ void __launch_bounds__(512, 2) fwd(Args a) {
    extern __shared__ __attribute__((aligned(16))) unsigned char lds_raw[];
    Frame F; F.lds = (LAS unsigned char*)lds_raw; F.tid = threadIdx.x; F.lane = F.tid & 63; F.wave = __builtin_amdgcn_readfirstlane(F.tid >> 6); F.G = gridDim.x; F.bid = blockIdx.x;
    for (int u = F.tid; u < (LDS_BYTES - LDS_CTL) / 4; u += 512) ((LAS unsigned*)(F.lds + LDS_CTL))[u] = 0u;
    __syncthreads();
    unsigned* ctl = (unsigned*)(a.ws + WS_CTL);
    XcdBarrier bar = xcd_barrier_post(ctl + 4096, (volatile LAS unsigned*)(F.lds + LDS_CTL));
    const int lo = a.ph_lo, hi = a.ph_hi;
#define IN(k) (lo <= (k) && (k) < hi)
#define SEAM(k) do { if (IN(k) && IN((k) + 1)) xcd_barrier(bar); } while (0)
    const int vcu = (F.G % 8 == 0) ? (F.bid % 8) * (F.G / 8) + F.bid / 8 : F.bid;
    if (IN(0)) { p0a(a, F); }
    SEAM(0);
    if (IN(1)) {
        p0b_rows(a, F);
        for (int u = F.bid; u < 256; u += F.G) compress_unit<0>(a, F, u >> 7, u & 127);
    }
    SEAM(1);
    if (IN(2)) {
        for (int u = F.bid; u < 112; u += F.G) sample_inproj_job(a, F, u);
        pg8::Gemm g{(const bf16_t*)(a.ws + WS_H), (const bf16_t*)(a.ws + WS_WINT), NPR, NIN_PAD, DM};
        pg8::StaticOrder S; S.init(NPR, NIN_PAD, F.G, F.bid);
        EpiIn E{a.out, a.ws};
        pg8::gemm_phase<EpiIn, pg8::StaticOrder, true, true>(F.lds, g, S, E);
    }
    SEAM(2);
    if (IN(3)) {
        for (int u = F.bid; u < 16; u += F.G) compress_unit<1>(a, F, u >> 3, u & 7);
        for (int u = vcu; u < 256; u += F.G) sample_unit(a, F, u >> 3, (u >> 2) & 1, u & 3);
        for (int u = vcu; u < 1024; u += F.G) { const int v = u & 255, k = u >> 8, s = v & 31; const int qb = k == 0 ? s : (k == 1 ? 63 - s : (k == 2 ? 64 + s : 127 - s));
            win_unit(a, F, v >> 6, (v >> 5) & 1, qb); }
        conv_rows(a, F);
    }
    SEAM(3);
    if (IN(4)) {
        for (int u = vcu; u < 1024; u += F.G) { const int v = u & 255, k = u >> 8, s = v & 31; const int qb = k == 0 ? s : (k == 1 ? 63 - s : (k == 2 ? 64 + s : 127 - s));
            nsa_unit(a, F, v >> 6, (v >> 5) & 1, qb); }
    }
    SEAM(4);
    if (IN(5)) {
        for (int u = F.bid; u < 64; u += F.G) sample_outproj_job(a, F, u);
        pg8::Gemm g{(const bf16_t*)(a.ws + WS_A2), (const bf16_t*)(a.ws + WS_WOUTT), NPR, DM, DMIX};
        pg8::StaticOrder S; S.init(NPR, DM, F.G, F.bid);
        EpiOut E{a.out, a.ws, a.x_prompt};
        pg8::gemm_phase<EpiOut, pg8::StaticOrder, true, true>(F.lds, g, S, E);
    }
    SEAM(5);
    if (IN(6)) { p5_rows(a, F); }
#undef IN
#undef SEAM
}

#ifndef MK_PER_PHASE
#define MK_PER_PHASE 0
#endif
extern "C" void kernel_launch(void* const* d_in, const int* in_sizes, int n_in, void* d_out, int out_size, void* d_ws, size_t ws_size, hipStream_t stream) {
    static int grid = 0;
    if (grid == 0) {
        if (n_in != 26 || (size_t)out_size != O_END || ws_size < WS_END) { fprintf(stderr, "kernel_launch: unexpected shapes: n_in %d out %d ws %zu\n", n_in, out_size, ws_size); grid = -1; return; }
        int dev = 0, cus = 0, per_cu = 0;
        if (hipGetDevice(&dev) != hipSuccess || hipDeviceGetAttribute(&cus, hipDeviceAttributeMultiprocessorCount, dev) != hipSuccess) { grid = -1; return; }
        if (hipFuncSetAttribute((const void*)fwd, hipFuncAttributeMaxDynamicSharedMemorySize, LDS_BYTES) != hipSuccess) { fprintf(stderr, "kernel_launch: hipFuncSetAttribute failed\n"); grid = -1; return; }
        if (hipOccupancyMaxActiveBlocksPerMultiprocessor(&per_cu, (const void*)fwd, 512, LDS_BYTES) != hipSuccess || per_cu < 1) { fprintf(stderr, "kernel_launch: occupancy query says %d\n", per_cu); }
        (void)hipGetLastError();
        grid = cus;
    }
    if (grid < 0) return;
    (void)hipMemsetAsync((char*)d_ws + WS_CTL, 0, CTL_ZERO_BYTES, stream);
    Args a{};
    a.x_prompt = (const float*)d_in[0]; a.x_sample = (const float*)d_in[1];
    a.cache_k_cmp = (const float*)d_in[2]; a.cache_v_cmp = (const float*)d_in[3]; a.cache_k_slc = (const float*)d_in[4]; a.cache_v_slc = (const float*)d_in[5];
    a.cache_k_win = (const float*)d_in[6]; a.cache_v_win = (const float*)d_in[7]; a.state_conv = (const float*)d_in[8]; a.page_table = (const int*)d_in[9];
    a.c_prompt = (const float*)d_in[10]; a.c_sample = (const float*)d_in[11]; a.ada_w = (const float*)d_in[12]; a.ada_b = (const float*)d_in[13]; a.norm_g = (const float*)d_in[14]; a.w_in = (const float*)d_in[15];
    a.cmp_pe_k = (const float*)d_in[16]; a.cmp_w1_k = (const float*)d_in[17]; a.cmp_w2_k = (const float*)d_in[18]; a.cmp_pe_v = (const float*)d_in[19]; a.cmp_w1_v = (const float*)d_in[20]; a.cmp_w2_v = (const float*)d_in[21];
    a.conv_w = (const float*)d_in[22]; a.w_out = (const float*)d_in[23]; a.rel_bias = (const float*)d_in[24]; a.final_g = (const float*)d_in[25];
    a.out = (float*)d_out; a.ws = (unsigned char*)d_ws;
#if MK_PER_PHASE
    for (int p = 0; p < NPHASE; ++p) { a.ph_lo = p; a.ph_hi = p + 1; hipLaunchKernelGGL(fwd, dim3(grid), dim3(512), LDS_BYTES, stream, a); }
#else
    a.ph_lo = 0; a.ph_hi = NPHASE;
    hipLaunchKernelGGL(fwd, dim3(grid), dim3(512), LDS_BYTES, stream, a);
#endif
#ifdef PROBE_REPEAT_PHASE
    a.ph_lo = PROBE_REPEAT_PHASE; a.ph_hi = PROBE_REPEAT_PHASE + 1;
    hipLaunchKernelGGL(fwd, dim3(grid), dim3(512), LDS_BYTES, stream, a);
#endif
    const hipError_t le = hipPeekAtLastError();
    if (le != hipSuccess) fprintf(stderr, "kernel_launch: launch failed: %s\n", hipGetErrorName(le));
}
```
